# Optimizing an MI355X kernel written in HIP

```python
import math
import jax, jax.numpy as jnp
from jax import lax
import numpy as np

D_MODEL = 1024
BATCH = 8
SEQ = 2048
DEPTH = 4
DEC_BATCH = 128
DEC_SEQ = 8
PAST_LEN = 16384
PAGE_SIZE = 128

N_MIXERS = 3
N_S5 = (DEPTH + 2) // 3
N_GLA = (DEPTH + 1) // 3
N_GDN = DEPTH // 3
NORM_EPS = 1e-6
D_FF = 4 * D_MODEL

S5_GROUP = 16
S5_GROUPS = D_MODEL // S5_GROUP
S5_STATE = 64
S5_DT_MIN = 0.001
S5_DT_MAX = 0.1

GLA_HEADS = 4
GLA_DK = (D_MODEL // 2) // GLA_HEADS
GLA_DV = D_MODEL // GLA_HEADS
GLA_KEY = GLA_HEADS * GLA_DK
GLA_VAL = GLA_HEADS * GLA_DV
GLA_GATE_RANK = 16
GLA_TAU = 16.0
GLA_CHUNK = 64
GLA_IN = 2 * GLA_KEY + 2 * GLA_VAL + GLA_GATE_RANK

GDN_DK = 128
GDN_DV = 128
GDN_QK_HEADS = D_MODEL // GDN_DK
GDN_V_HEADS = 2 * GDN_QK_HEADS
GDN_KEY = GDN_QK_HEADS * GDN_DK
GDN_VAL = GDN_V_HEADS * GDN_DV
GDN_CONV = 4
GDN_CONV_DIM = 2 * GDN_KEY + GDN_VAL
GDN_CHUNK = 64
GDN_IN = GDN_CONV_DIM + GDN_VAL + 2 * GDN_V_HEADS

kernel_name = 'hybrid_s5_gla_gdn_decoder_step'


def rmsnorm(x, gain):
    xf = x.astype(jnp.float32)
    y = xf * lax.rsqrt(jnp.mean(xf * xf, axis=-1, keepdims=True) + NORM_EPS)
    return (y * gain.astype(jnp.float32)).astype(x.dtype)


def l2norm(x):
    return x * lax.rsqrt(jnp.sum(x * x, axis=-1, keepdims=True) + NORM_EPS)


def _chunk_len(L, c):
    return c if L % c == 0 else L


def _to_chunks(t, c):
    B, L = t.shape[:2]
    return jnp.moveaxis(t.reshape((B, L // c, c) + t.shape[2:]), 1, 0)


def _from_chunks(t):
    N, B, c = t.shape[:3]
    return jnp.moveaxis(t, 0, 1).reshape((B, N * c) + t.shape[3:])


def s5_mixer(h, s0_re, s0_im, a_re, a_im, log_dt, b_re, b_im, c_re, c_im, d_skip, w_glu):
    Bsz, L, _ = h.shape
    f32 = jnp.float32
    dt = jnp.exp(log_dt.astype(f32))[:, None]
    A = lax.complex(a_re.astype(f32), a_im.astype(f32))
    a_bar = jnp.exp(A * dt)
    Bm = lax.complex(b_re.astype(f32), b_im.astype(f32))
    b_bar = ((a_bar - 1.0) / A)[..., None] * Bm
    u = h.astype(f32).reshape(Bsz, L, S5_GROUPS, S5_GROUP)
    bu = jnp.einsum('gpc,blgc->blgp', b_bar, u.astype(jnp.complex64))
    s0 = lax.complex(s0_re.astype(f32), s0_im.astype(f32))
    bu = bu.at[:, 0].add(a_bar * s0)
    a_seq = jnp.broadcast_to(a_bar, (1, L) + a_bar.shape)

    def combine(e1, e2):
        a1, x1 = e1
        a2, x2 = e2
        return a2 * a1, a2 * x1 + x2

    _, states = lax.associative_scan(combine, (a_seq, bu), axis=1)
    Cm = lax.complex(c_re.astype(f32), c_im.astype(f32))
    y = jnp.einsum('gcp,blgp->blgc', Cm, states).real.reshape(Bsz, L, D_MODEL)
    y = y + d_skip.astype(f32) * h.astype(f32)
    g = jax.nn.gelu(y).astype(h.dtype)
    gv = g @ w_glu
    out = gv[..., :D_MODEL] * jax.nn.sigmoid(gv[..., D_MODEL:])
    s_last = states[:, -1]
    return out, s_last.real, s_last.imag


def gla_chunk_step(S, inp):
    q, k, v, g = inp
    C = q.shape[1]
    b = jnp.cumsum(g, axis=1)
    causal = jnp.tril(jnp.ones((C, C), bool))[None, :, :, None, None]
    diff = b[:, :, None] - b[:, None, :]
    decay = jnp.exp(jnp.where(causal, diff, -jnp.inf))
    att = jnp.einsum('bthk,bshk,btshk->bhts', q, k, decay)
    o = (jnp.einsum('bthk,bhkv->bthv', q * jnp.exp(b), S)
         + jnp.einsum('bhts,bshv->bthv', att, v))
    b_last = b[:, -1]
    S = (jnp.exp(b_last)[..., None] * S
         + jnp.einsum('bshk,bshv->bhkv', k * jnp.exp(b_last[:, None] - b), v))
    return S, o


def gla_mixer(h, s0, w_in, w_gate_up, b_gate, norm_o, w_out):
    Bsz, L, _ = h.shape
    f32 = jnp.float32
    p = h @ w_in
    q, k, v, r, gl = jnp.split(p, [GLA_KEY, 2 * GLA_KEY, 2 * GLA_KEY + GLA_VAL,
                                   2 * GLA_KEY + 2 * GLA_VAL], axis=-1)
    g = jax.nn.log_sigmoid((gl @ w_gate_up + b_gate).astype(f32)) / GLA_TAU
    q = q.astype(f32).reshape(Bsz, L, GLA_HEADS, GLA_DK) * (GLA_DK ** -0.5)
    k = k.astype(f32).reshape(Bsz, L, GLA_HEADS, GLA_DK)
    v = v.astype(f32).reshape(Bsz, L, GLA_HEADS, GLA_DV)
    g = g.reshape(Bsz, L, GLA_HEADS, GLA_DK)
    c = _chunk_len(L, GLA_CHUNK)
    xs = (_to_chunks(q, c), _to_chunks(k, c), _to_chunks(v, c), _to_chunks(g, c))
    S, o = lax.scan(gla_chunk_step, s0.astype(f32), xs)
    o = rmsnorm(_from_chunks(o), norm_o)
    o = o * jax.nn.silu(r.astype(f32).reshape(Bsz, L, GLA_HEADS, GLA_DV))
    out = o.reshape(Bsz, L, GLA_VAL).astype(h.dtype) @ w_out
    return out, S


def gdn_chunk_step(S, inp):
    q, k, v, beta, g = inp
    C = q.shape[1]
    G = jnp.cumsum(g, axis=1)
    Gh = jnp.moveaxis(G, 2, 1)
    tri = jnp.tril(jnp.ones((C, C), bool))
    strict = jnp.tril(jnp.ones((C, C), bool), -1)
    decay = jnp.exp(jnp.where(tri, Gh[..., :, None] - Gh[..., None, :], -jnp.inf))
    kk = jnp.einsum('bthk,bshk->bhts', k, k)
    bh = jnp.moveaxis(beta, 2, 1)
    M = jnp.where(strict, kk * decay * bh[..., :, None], 0.0)
    lhs = M + jnp.eye(C, dtype=M.dtype)
    rhs = jnp.concatenate([jnp.moveaxis(v * beta[..., None], 1, 2),
                           jnp.moveaxis(k * (beta * jnp.exp(G))[..., None], 1, 2)], axis=-1)
    uw = lax.linalg.triangular_solve(lhs, rhs, left_side=True, lower=True, unit_diagonal=True)
    u, w = uw[..., :GDN_DV], uw[..., GDN_DV:]
    v_new = u - jnp.einsum('bhtk,bhkv->bhtv', w, S)
    qk = jnp.einsum('bthk,bshk->bhts', q, k) * decay
    o = (jnp.einsum('bthk,bhkv->bhtv', q * jnp.exp(G)[..., None], S)
         + jnp.einsum('bhts,bhsv->bhtv', qk, v_new))
    k_dec = k * jnp.exp(G[:, -1:, :] - G)[..., None]
    S = jnp.exp(Gh[..., -1])[..., None, None] * S + jnp.einsum('bshk,bhsv->bhkv', k_dec, v_new)
    return S, jnp.moveaxis(o, 1, 2)


def gdn_mixer(h, s0, conv0, w_in, conv_w, a_log, dt_bias, norm_o, w_out):
    Bsz, L, _ = h.shape
    f32 = jnp.float32
    p = h @ w_in
    qkv, z, b_raw, a_raw = jnp.split(p, [GDN_CONV_DIM, GDN_CONV_DIM + GDN_VAL,
                                         GDN_CONV_DIM + GDN_VAL + GDN_V_HEADS], axis=-1)
    xp = jnp.concatenate([conv0.astype(f32), qkv.astype(f32)], axis=1)
    cw = conv_w.astype(f32)
    conv = jax.nn.silu(sum(xp[:, j:j + L] * cw[j] for j in range(GDN_CONV)))
    new_conv = xp[:, L:]
    q, k, v = jnp.split(conv, [GDN_KEY, 2 * GDN_KEY], axis=-1)
    rep = GDN_V_HEADS // GDN_QK_HEADS
    q = jnp.repeat(l2norm(q.reshape(Bsz, L, GDN_QK_HEADS, GDN_DK)) * (GDN_DK ** -0.5), rep, axis=2)
    k = jnp.repeat(l2norm(k.reshape(Bsz, L, GDN_QK_HEADS, GDN_DK)), rep, axis=2)
    v = v.reshape(Bsz, L, GDN_V_HEADS, GDN_DV)
    beta = jax.nn.sigmoid(b_raw.astype(f32))
    g = -jnp.exp(a_log.astype(f32)) * jax.nn.softplus(a_raw.astype(f32) + dt_bias.astype(f32))
    c = _chunk_len(L, GDN_CHUNK)
    xs = (_to_chunks(q, c), _to_chunks(k, c), _to_chunks(v, c), _to_chunks(beta, c), _to_chunks(g, c))
    S, o = lax.scan(gdn_chunk_step, s0.astype(f32), xs)
    o = rmsnorm(_from_chunks(o), norm_o) * jax.nn.silu(z.astype(f32).reshape(Bsz, L, GDN_V_HEADS, GDN_DV))
    out = o.reshape(Bsz, L, GDN_VAL).astype(h.dtype) @ w_out
    return out, S, new_conv


def trunk(x, s5_re, s5_im, gla_s, gdn_s, gdn_conv, weights):
    (norm_mix, norm_ffn, norm_final, w_up, w_down,
     s5_a_re, s5_a_im, s5_log_dt, s5_b_re, s5_b_im, s5_c_re, s5_c_im, s5_d, s5_w_glu,
     gla_w_in, gla_w_gate_up, gla_b_gate, gla_norm, gla_w_out,
     gdn_w_in, gdn_conv_w, gdn_a_log, gdn_dt_bias, gdn_norm, gdn_w_out) = weights
    h = x
    o_s5_re, o_s5_im, o_gla, o_gdn, o_conv = [], [], [], [], []
    for i in range(DEPTH):
        kind, j = i % N_MIXERS, i // N_MIXERS
        hn = rmsnorm(h, norm_mix[i])
        if kind == 0:
            mix, sr, si = s5_mixer(hn, s5_re[j], s5_im[j], s5_a_re[j], s5_a_im[j], s5_log_dt[j],
                                   s5_b_re[j], s5_b_im[j], s5_c_re[j], s5_c_im[j], s5_d[j], s5_w_glu[j])
            o_s5_re.append(sr.astype(s5_re.dtype))
            o_s5_im.append(si.astype(s5_im.dtype))
        elif kind == 1:
            mix, S = gla_mixer(hn, gla_s[j], gla_w_in[j], gla_w_gate_up[j], gla_b_gate[j],
                               gla_norm[j], gla_w_out[j])
            o_gla.append(S.astype(gla_s.dtype))
        else:
            mix, S, cv = gdn_mixer(hn, gdn_s[j], gdn_conv[j], gdn_w_in[j], gdn_conv_w[j], gdn_a_log[j],
                                   gdn_dt_bias[j], gdn_norm[j], gdn_w_out[j])
            o_gdn.append(S.astype(gdn_s.dtype))
            o_conv.append(cv.astype(gdn_conv.dtype))
        h = h + mix
        hn = rmsnorm(h, norm_ffn[i])
        h = h + jnp.square(jax.nn.relu(hn @ w_up[i])) @ w_down[i]
    y = rmsnorm(h, norm_final)
    return y, jnp.stack(o_s5_re), jnp.stack(o_s5_im), jnp.stack(o_gla), jnp.stack(o_gdn), jnp.stack(o_conv)


def setup_inputs(seed: int = 0) -> dict:
    key = jax.random.key(seed)
    ks = iter(jax.random.split(key, 40))
    nrm = lambda shape, s: jax.random.normal(next(ks), shape, jnp.float32) * s
    n_idx = jnp.arange(S5_STATE, dtype=jnp.float32)
    gdn_dt = jnp.exp(jax.random.uniform(next(ks), (N_GDN, GDN_V_HEADS), jnp.float32,
                                        math.log(0.001), math.log(0.1)))
    return {
        'x_prompt': nrm((BATCH, SEQ, D_MODEL), 1.0),
        'x_sample': nrm((DEC_BATCH, DEC_SEQ, D_MODEL), 1.0),
        'state_s5_re': nrm((N_S5, DEC_BATCH, S5_GROUPS, S5_STATE), 0.5),
        'state_s5_im': nrm((N_S5, DEC_BATCH, S5_GROUPS, S5_STATE), 0.5),
        'state_gla': nrm((N_GLA, DEC_BATCH, GLA_HEADS, GLA_DK, GLA_DV), 0.3),
        'state_gdn': nrm((N_GDN, DEC_BATCH, GDN_V_HEADS, GDN_DK, GDN_DV), 0.3),
        'state_gdn_conv': nrm((N_GDN, DEC_BATCH, GDN_CONV - 1, GDN_CONV_DIM), 1.0),
        'norm_mix': 1.0 + nrm((DEPTH, D_MODEL), 0.01),
        'norm_ffn': 1.0 + nrm((DEPTH, D_MODEL), 0.01),
        'norm_final': 1.0 + nrm((D_MODEL,), 0.01),
        'w_up': nrm((DEPTH, D_MODEL, D_FF), D_MODEL ** -0.5),
        'w_down': nrm((DEPTH, D_FF, D_MODEL), 0.5 * D_FF ** -0.5),
        's5_a_re': -0.5 + nrm((N_S5, S5_GROUPS, S5_STATE), 0.01),
        's5_a_im': math.pi * n_idx + nrm((N_S5, S5_GROUPS, S5_STATE), 0.01),
        's5_log_dt': jax.random.uniform(next(ks), (N_S5, S5_GROUPS), jnp.float32,
                                        math.log(S5_DT_MIN), math.log(S5_DT_MAX)),
        's5_b_re': nrm((N_S5, S5_GROUPS, S5_STATE, S5_GROUP), (2 * S5_GROUP) ** -0.5),
        's5_b_im': nrm((N_S5, S5_GROUPS, S5_STATE, S5_GROUP), (2 * S5_GROUP) ** -0.5),
        's5_c_re': nrm((N_S5, S5_GROUPS, S5_GROUP, S5_STATE), S5_STATE ** -0.5),
        's5_c_im': nrm((N_S5, S5_GROUPS, S5_GROUP, S5_STATE), S5_STATE ** -0.5),
        's5_d': nrm((N_S5, D_MODEL), 1.0),
        's5_w_glu': nrm((N_S5, D_MODEL, 2 * D_MODEL), D_MODEL ** -0.5),
        'gla_w_in': nrm((N_GLA, D_MODEL, GLA_IN), D_MODEL ** -0.5),
        'gla_w_gate_up': nrm((N_GLA, GLA_GATE_RANK, GLA_KEY), GLA_GATE_RANK ** -0.5),
        'gla_b_gate': nrm((N_GLA, GLA_KEY), 0.1),
        'gla_norm': 1.0 + nrm((N_GLA, GLA_DV), 0.01),
        'gla_w_out': nrm((N_GLA, GLA_VAL, D_MODEL), GLA_VAL ** -0.5),
        'gdn_w_in': nrm((N_GDN, D_MODEL, GDN_IN), D_MODEL ** -0.5),
        'gdn_conv_w': nrm((N_GDN, GDN_CONV, GDN_CONV_DIM), GDN_CONV ** -0.5),
        'gdn_a_log': jnp.log(jax.random.uniform(next(ks), (N_GDN, GDN_V_HEADS), jnp.float32, 1.0, 16.0)),
        'gdn_dt_bias': gdn_dt + jnp.log(-jnp.expm1(-gdn_dt)),
        'gdn_norm': 1.0 + nrm((N_GDN, GDN_DV), 0.01),
        'gdn_w_out': nrm((N_GDN, GDN_VAL, D_MODEL), GDN_VAL ** -0.5),
    }


def reference(x_prompt, x_sample, state_s5_re, state_s5_im, state_gla, state_gdn, state_gdn_conv,
              norm_mix, norm_ffn, norm_final, w_up, w_down,
              s5_a_re, s5_a_im, s5_log_dt, s5_b_re, s5_b_im, s5_c_re, s5_c_im, s5_d, s5_w_glu,
              gla_w_in, gla_w_gate_up, gla_b_gate, gla_norm, gla_w_out,
              gdn_w_in, gdn_conv_w, gdn_a_log, gdn_dt_bias, gdn_norm, gdn_w_out):
    weights = (norm_mix, norm_ffn, norm_final, w_up, w_down,
               s5_a_re, s5_a_im, s5_log_dt, s5_b_re, s5_b_im, s5_c_re, s5_c_im, s5_d, s5_w_glu,
               gla_w_in, gla_w_gate_up, gla_b_gate, gla_norm, gla_w_out,
               gdn_w_in, gdn_conv_w, gdn_a_log, gdn_dt_bias, gdn_norm, gdn_w_out)
    Bp = x_prompt.shape[0]
    dt = x_prompt.dtype
    z_s5 = jnp.zeros((N_S5, Bp, S5_GROUPS, S5_STATE), dt)
    z_gla = jnp.zeros((N_GLA, Bp, GLA_HEADS, GLA_DK, GLA_DV), dt)
    z_gdn = jnp.zeros((N_GDN, Bp, GDN_V_HEADS, GDN_DK, GDN_DV), dt)
    z_conv = jnp.zeros((N_GDN, Bp, GDN_CONV - 1, GDN_CONV_DIM), dt)
    y_p, s5r_p, s5i_p, gla_p, gdn_p, conv_p = trunk(x_prompt, z_s5, z_s5, z_gla, z_gdn, z_conv, weights)
    y_s, s5r_s, s5i_s, gla_s, gdn_s, conv_s = trunk(x_sample, state_s5_re, state_s5_im, state_gla,
                                                    state_gdn, state_gdn_conv, weights)
    return (y_p, y_s, s5r_p, s5i_p, gla_p, gdn_p, conv_p, s5r_s, s5i_s, gla_s, gdn_s, conv_s)
```

```cpp
#include <hip/hip_runtime.h>
#include <hip/hip_cooperative_groups.h>
#include <cstdio>
#include <cstdint>
namespace cg = cooperative_groups;

typedef unsigned short bf16_t;
typedef short bf16x8 __attribute__((ext_vector_type(8)));
typedef float f32x16 __attribute__((ext_vector_type(16)));
#define DI __device__ __forceinline__
#ifndef DUP_UP
#define DUP_UP 1
#endif
#ifndef DUP_REC
#define DUP_REC 1
#endif
#ifndef DUP_SYNC
#define DUP_SYNC 1
#endif
#ifndef DUP_MISC
#define DUP_MISC 1
#endif
#ifndef DUP_G2
#define DUP_G2 1
#endif
#define GSYNC() do { for (int rs_ = 0; rs_ < DUP_SYNC; ++rs_) xcd_barrier(xb); } while (0)
#define REPM for (int rm_ = 0; rm_ < DUP_MISC; ++rm_)
#ifndef DUP_M1
#define DUP_M1 1
#endif
#ifndef DUP_M2
#define DUP_M2 1
#endif
#ifndef DUP_M3
#define DUP_M3 1
#endif
#ifndef DUP_M4
#define DUP_M4 1
#endif
#define REPM1 for (int rm1_ = 0; rm1_ < DUP_M1; ++rm1_)
#define REPM2 for (int rm2_ = 0; rm2_ < DUP_M2; ++rm2_)
#define REPM3 for (int rm3_ = 0; rm3_ < DUP_M3; ++rm3_)
#define REPM4 for (int rm4_ = 0; rm4_ < DUP_M4; ++rm4_)
#define REPG for (int rg_ = 0; rg_ < DUP_G2; ++rg_)

constexpr int NP = 16384;
constexpr int MT = 17408;
constexpr int NR = 2176;
constexpr size_t O_YP = 0, O_YS = 16777216, O_S5RP = 17825792, O_S5IP = 17891328, O_GLAP = 17956864, O_GDNP = 19005440,
                 O_CONVP = 21102592, O_S5RS = 21200896, O_S5IS = 22249472, O_GLAS = 23298048, O_GDNS = 40075264, O_CONVS = 73629696;
constexpr size_t W_UP = 0, W_DOWN = 8388608, W_MIXIN = 16777216, W_MIXOUT = 30408704, W_S5MAT = 34603008, W_H = 50331648, W_SB = 127926272;
constexpr size_t W_BAR = 47251456;
constexpr size_t S5MAT_STRIDE = 6324224, S5_WCAT = 0, S5_WST = 4194304, S5_AP8 = 6291456;
constexpr size_t WS_NEED = W_SB + 395640832;
constexpr size_t SC_HN = 0, SC_ACT = 37748736;
constexpr size_t SC_UP = 0, SC_SLOC = 75497472, SC_GBUF = 154140672;
constexpr size_t SC_GLA_P = 37748736, SC_GLA_GL = 152043520, SC_GLA_GATE = 154140672, SC_GLA_O = 190840832;
constexpr size_t SC_GLA_QT = 262144000, SC_GLA_KTL = 278921216, SC_GLA_KDT = 295698432, SC_GLA_DL = 312475648, SC_GLA_AQK = 312999936;
constexpr size_t SC_GDN_PRE = 0, SC_GDN_Z = 142606336, SC_GDN_BA = 213909504, SC_GDN_QKV = 216137728;
constexpr size_t SC_GDN_OM = 0, SC_GDN_AQK = 71303168, SC_GDN_TINV = 104857600, SC_GDN_KT = 358744064, SC_GDN_GATES = 392298496;

struct Params { const float* in[32]; float* out; char* ws; };

typedef __bf16 hbf16x2_t __attribute__((ext_vector_type(2)));
typedef float hf32x2_t __attribute__((ext_vector_type(2)));
typedef unsigned u32x4_t __attribute__((ext_vector_type(4)));
DI unsigned pack2(float a, float b) { hf32x2_t v = {a, b}; return __builtin_bit_cast(unsigned, __builtin_convertvector(v, hbf16x2_t)); }
DI bf16_t f2bf(float x) { return (bf16_t)(pack2(x, 0.f) & 0xffffu); }
DI float bf2f(bf16_t b) { return __uint_as_float(((unsigned)b) << 16); }

DI float sigmoidf_(float x) { return 1.0f / (1.0f + __expf(-x)); }
DI float softplusf_(float x) { return fmaxf(x, 0.f) + log1pf(__expf(-fabsf(x))); }
DI int otid() { int t = __builtin_amdgcn_workitem_id_x(); asm volatile("" : "+v"(t)); return t; }
DI int swap23(int k) { return (k & ~12) | ((k & 4) << 1) | ((k & 8) >> 1); }
DI int crow(int reg, int hh) { return (reg & 3) + 8 * (reg >> 2) + 4 * hh; }
template <int SS> DI bf16x8 pack8(const f32x16& x) {
  u32x4_t r; r.x = pack2(x[8 * SS], x[8 * SS + 1]); r.y = pack2(x[8 * SS + 2], x[8 * SS + 3]); r.z = pack2(x[8 * SS + 4], x[8 * SS + 5]); r.w = pack2(x[8 * SS + 6], x[8 * SS + 7]);
  return __builtin_bit_cast(bf16x8, r); }
DI float wave_sum(float v) {
#pragma unroll
  for (int o = 32; o > 0; o >>= 1) v += __shfl_xor(v, o);
  return v;
}

constexpr int LSTR = 72;
constexpr int TILE_E = 128 * LSTR;

template <class Epi>
DI void gemm_tile(const bf16_t* __restrict__ A, int lda, const bf16_t* __restrict__ Bt, int ldb, int K, const Epi& epi, bf16_t* smem) {
  const int tid = otid(), lane = tid & 63, wid = tid >> 6, wr = wid >> 1, wc = wid & 1;
  const int lr = tid >> 3, lc = (tid & 7) * 8;
  f32x16 acc[2][2];
#pragma unroll
  for (int i = 0; i < 2; ++i)
#pragma unroll
    for (int j = 0; j < 2; ++j)
#pragma unroll
      for (int r = 0; r < 16; ++r) acc[i][j][r] = 0.f;
  uint4 a00, b00, a01, b01, a02, b02, a03, b03, a10, b10, a11, b11, a12, b12, a13, b13;
  const bf16_t* Ap = A + (size_t)lr * lda + lc;
  const bf16_t* Bp = Bt + (size_t)lr * ldb + lc;
  const int nk = K >> 6;
      a00 = *(const uint4*)(Ap + (size_t)(0) * lda + 0); b00 = *(const uint4*)(Bp + (size_t)(0) * ldb + 0);
      a01 = *(const uint4*)(Ap + (size_t)(32) * lda + 0); b01 = *(const uint4*)(Bp + (size_t)(32) * ldb + 0);
      a02 = *(const uint4*)(Ap + (size_t)(64) * lda + 0); b02 = *(const uint4*)(Bp + (size_t)(64) * ldb + 0);
      a03 = *(const uint4*)(Ap + (size_t)(96) * lda + 0); b03 = *(const uint4*)(Bp + (size_t)(96) * ldb + 0);
      a10 = *(const uint4*)(Ap + (size_t)(0) * lda + 64); b10 = *(const uint4*)(Bp + (size_t)(0) * ldb + 64);
      a11 = *(const uint4*)(Ap + (size_t)(32) * lda + 64); b11 = *(const uint4*)(Bp + (size_t)(32) * ldb + 64);
      a12 = *(const uint4*)(Ap + (size_t)(64) * lda + 64); b12 = *(const uint4*)(Bp + (size_t)(64) * ldb + 64);
      a13 = *(const uint4*)(Ap + (size_t)(96) * lda + 64); b13 = *(const uint4*)(Bp + (size_t)(96) * ldb + 64);
      { bf16_t* da = smem + 0 * 2 * TILE_E; bf16_t* db = da + TILE_E;
        *(uint4*)(da + (lr + 0) * LSTR + lc) = a00; *(uint4*)(db + (lr + 0) * LSTR + lc) = b00;
        *(uint4*)(da + (lr + 32) * LSTR + lc) = a01; *(uint4*)(db + (lr + 32) * LSTR + lc) = b01;
        *(uint4*)(da + (lr + 64) * LSTR + lc) = a02; *(uint4*)(db + (lr + 64) * LSTR + lc) = b02;
        *(uint4*)(da + (lr + 96) * LSTR + lc) = a03; *(uint4*)(db + (lr + 96) * LSTR + lc) = b03;
      }
  __syncthreads();
  for (int kt = 0; kt < nk; kt += 2) {
    {
      const int kn = min(kt + 2, nk - 1) << 6;
      a00 = *(const uint4*)(Ap + (size_t)(0) * lda + kn); b00 = *(const uint4*)(Bp + (size_t)(0) * ldb + kn);
      a01 = *(const uint4*)(Ap + (size_t)(32) * lda + kn); b01 = *(const uint4*)(Bp + (size_t)(32) * ldb + kn);
      a02 = *(const uint4*)(Ap + (size_t)(64) * lda + kn); b02 = *(const uint4*)(Bp + (size_t)(64) * ldb + kn);
      a03 = *(const uint4*)(Ap + (size_t)(96) * lda + kn); b03 = *(const uint4*)(Bp + (size_t)(96) * ldb + kn);
      { const bf16_t* sa = smem + 0 * 2 * TILE_E; const bf16_t* sb = sa + TILE_E;
#pragma unroll
      for (int kk = 0; kk < 4; ++kk) {
        bf16x8 af[2], bfr[2];
#pragma unroll
        for (int i = 0; i < 2; ++i) af[i] = *(const bf16x8*)(sa + (wr * 64 + i * 32 + (lane & 31)) * LSTR + kk * 16 + (lane >> 5) * 8);
#pragma unroll
        for (int j = 0; j < 2; ++j) bfr[j] = *(const bf16x8*)(sb + (wc * 64 + j * 32 + (lane & 31)) * LSTR + kk * 16 + (lane >> 5) * 8);
#pragma unroll
        for (int i = 0; i < 2; ++i)
#pragma unroll
          for (int j = 0; j < 2; ++j) acc[i][j] = __builtin_amdgcn_mfma_f32_32x32x16_bf16(af[i], bfr[j], acc[i][j], 0, 0, 0);
      } }
      { bf16_t* da = smem + 1 * 2 * TILE_E; bf16_t* db = da + TILE_E;
        *(uint4*)(da + (lr + 0) * LSTR + lc) = a10; *(uint4*)(db + (lr + 0) * LSTR + lc) = b10;
        *(uint4*)(da + (lr + 32) * LSTR + lc) = a11; *(uint4*)(db + (lr + 32) * LSTR + lc) = b11;
        *(uint4*)(da + (lr + 64) * LSTR + lc) = a12; *(uint4*)(db + (lr + 64) * LSTR + lc) = b12;
        *(uint4*)(da + (lr + 96) * LSTR + lc) = a13; *(uint4*)(db + (lr + 96) * LSTR + lc) = b13;
      }
      __syncthreads();
    }
    {
      const int kn = min(kt + 3, nk - 1) << 6;
      a10 = *(const uint4*)(Ap + (size_t)(0) * lda + kn); b10 = *(const uint4*)(Bp + (size_t)(0) * ldb + kn);
      a11 = *(const uint4*)(Ap + (size_t)(32) * lda + kn); b11 = *(const uint4*)(Bp + (size_t)(32) * ldb + kn);
      a12 = *(const uint4*)(Ap + (size_t)(64) * lda + kn); b12 = *(const uint4*)(Bp + (size_t)(64) * ldb + kn);
      a13 = *(const uint4*)(Ap + (size_t)(96) * lda + kn); b13 = *(const uint4*)(Bp + (size_t)(96) * ldb + kn);
      { const bf16_t* sa = smem + 1 * 2 * TILE_E; const bf16_t* sb = sa + TILE_E;
#pragma unroll
      for (int kk = 0; kk < 4; ++kk) {
        bf16x8 af[2], bfr[2];
#pragma unroll
        for (int i = 0; i < 2; ++i) af[i] = *(const bf16x8*)(sa + (wr * 64 + i * 32 + (lane & 31)) * LSTR + kk * 16 + (lane >> 5) * 8);
#pragma unroll
        for (int j = 0; j < 2; ++j) bfr[j] = *(const bf16x8*)(sb + (wc * 64 + j * 32 + (lane & 31)) * LSTR + kk * 16 + (lane >> 5) * 8);
#pragma unroll
        for (int i = 0; i < 2; ++i)
#pragma unroll
          for (int j = 0; j < 2; ++j) acc[i][j] = __builtin_amdgcn_mfma_f32_32x32x16_bf16(af[i], bfr[j], acc[i][j], 0, 0, 0);
      } }
      { bf16_t* da = smem + 0 * 2 * TILE_E; bf16_t* db = da + TILE_E;
        *(uint4*)(da + (lr + 0) * LSTR + lc) = a00; *(uint4*)(db + (lr + 0) * LSTR + lc) = b00;
        *(uint4*)(da + (lr + 32) * LSTR + lc) = a01; *(uint4*)(db + (lr + 32) * LSTR + lc) = b01;
        *(uint4*)(da + (lr + 64) * LSTR + lc) = a02; *(uint4*)(db + (lr + 64) * LSTR + lc) = b02;
        *(uint4*)(da + (lr + 96) * LSTR + lc) = a03; *(uint4*)(db + (lr + 96) * LSTR + lc) = b03;
      }
      __syncthreads();
    }
  }
#pragma unroll
  for (int i = 0; i < 2; ++i)
#pragma unroll
    for (int r = 0; r < 16; ++r) {
      const int row = wr * 64 + i * 32 + (r & 3) + 8 * (r >> 2) + 4 * (lane >> 5);
      epi(row, wc * 64 + (lane & 31), acc[i][0][r], acc[i][1][r]);
    }
}

struct EpiRelu2 { bf16_t* act; int m0, n0;
  DI void operator()(int row, int col, float v0, float v1) const {
    bf16_t* d = act + (size_t)(m0 + row) * 4096 + n0 + col; float a = fmaxf(v0, 0.f), b = fmaxf(v1, 0.f); d[0] = f2bf(a * a); d[32] = f2bf(b * b); } };
struct EpiResid { float* h; int m0, n0;
  DI void operator()(int row, int col, float v0, float v1) const { float* d = h + (size_t)(m0 + row) * 1024 + n0 + col; d[0] += v0; d[32] += v1; } };
struct EpiGLU { float* h; int m0, n0;
  DI void operator()(int row, int col, float v0, float v1) const { const int n = n0 + col; float* d = h + (size_t)(m0 + row) * 1024 + (n >> 6) * 32 + (n & 31); d[0] += v0 * sigmoidf_(v1); } };
struct EpiGlaIn { bf16_t* P; float* GL; int m0, n0;
  DI void one(int row, int n, float v) const { if (n < 3072) P[(size_t)(m0 + row) * 3072 + n] = f2bf(v); else if (n < 3088) GL[(size_t)(m0 + row) * 16 + (n - 3072)] = v; }
  DI void operator()(int row, int col, float v0, float v1) const { one(row, n0 + col, v0); one(row, n0 + col + 32, v1); } };
struct EpiGdnIn { bf16_t* PRE; bf16_t* Z; float* BA; float* convp; float* convs; int m0, n0;
  DI void one(int tok, int n, float v) const {
    if (n < 4096) {
      PRE[(size_t)tok * 4096 + n] = f2bf(v);
      if (tok < NP) { const int l = tok & 2047; if (l >= 2045) convp[((size_t)(tok >> 11) * 3 + (l - 2045)) * 4096 + n] = v; }
      else { const int ts = tok - NP, l = ts & 7; if (l >= 5) convs[((size_t)(ts >> 3) * 3 + (l - 5)) * 4096 + n] = v; }
    } else if (n < 6144) Z[(size_t)tok * 2048 + (n - 4096)] = f2bf(v);
    else if (n < 6176) BA[(size_t)tok * 32 + (n - 6144)] = v;
  }
  DI void operator()(int row, int col, float v0, float v1) const { one(m0 + row, n0 + col, v0); one(m0 + row, n0 + col + 32, v1); } };
struct EpiS5Loc { float* sloc; int m0, g;
  DI void operator()(int row, int col, float v0, float v1) const { float* d = sloc + ((size_t)(m0 + row) * 64 + g) * 128 + col; d[0] = v0; d[32] = v1; } };
DI float gelu_tanh(float y) { return 0.5f * y * (1.0f + tanhf(0.7978845608028654f * (y + 0.044715f * y * y * y))); }
struct EpiS5Out { const bf16_t* up; const float* dsk; bf16_t* gbuf; int m0, g;
  DI void one(int r, int n, float v) const {
    const int t = n >> 4, c = n & 15, ch = g * 16 + c;
    const float hn = bf2f(up[((size_t)g * NR + r) * 256 + n]);
    gbuf[(size_t)(r * 8 + t) * 1024 + ch] = f2bf(gelu_tanh(v + dsk[ch] * hn));
  }
  DI void operator()(int row, int col, float v0, float v1) const { one(m0 + row, col, v0); one(m0 + row, col + 32, v1); } };

template <int MODE>
DI void convert_w(const float* __restrict__ W, int K, int N, bf16_t* __restrict__ Wt, int Npad, float* tilef) {
  bf16_t* tileS = (bf16_t*)tilef;
  const int nkt = K >> 6, nnt = (Npad + 511) >> 9, nt = nkt * nnt;
  const int tid = otid(), lane = tid & 63, wid = tid >> 6;
  for (int t = blockIdx.x; t < nt; t += gridDim.x) {
    const int kt = t % nkt, ntile = t / nkt, k0 = kt << 6, n0 = ntile << 9;
    int srcc[2]; float msk[2];
#pragma unroll
    for (int q = 0; q < 2; ++q) {
      const int nd = n0 + 4 * (lane + 64 * q);
      const int src = (MODE == 1) ? (((nd >> 5) & 1) * 1024 + (nd >> 6) * 32 + (nd & 31)) : nd;
      const bool ok = nd < N;
      srcc[q] = ok ? src : 0; msk[q] = ok ? 1.0f : 0.0f;
    }
#pragma unroll
    for (int hb = 0; hb < 2; ++hb) {
      float4 v[8][2];
#pragma unroll
      for (int r = 0; r < 8; ++r)
#pragma unroll
        for (int q = 0; q < 2; ++q) v[r][q] = *(const float4*)(W + (size_t)(k0 + wid * 16 + hb * 8 + r) * N + srcc[q]);
#pragma unroll
      for (int r = 0; r < 8; r += 2)
#pragma unroll
        for (int q = 0; q < 2; ++q) {
          const int row = wid * 16 + hb * 8 + r, nl = 4 * (lane + 64 * q);
          const float m = msk[q];
          *(unsigned*)(tileS + (nl + 0) * 68 + row) = pack2(v[r][q].x * m, v[r + 1][q].x * m);
          *(unsigned*)(tileS + (nl + 1) * 68 + row) = pack2(v[r][q].y * m, v[r + 1][q].y * m);
          *(unsigned*)(tileS + (nl + 2) * 68 + row) = pack2(v[r][q].z * m, v[r + 1][q].z * m);
          *(unsigned*)(tileS + (nl + 3) * 68 + row) = pack2(v[r][q].w * m, v[r + 1][q].w * m);
        }
    }
    __syncthreads();
#pragma unroll 4
    for (int u = 0; u < 16; ++u) {
      const int nl = (tid >> 3) + 32 * u, kc = (tid & 7) * 8;
      if (n0 + nl < Npad) {
        const uint2 a = *(const uint2*)(tileS + nl * 68 + kc), b = *(const uint2*)(tileS + nl * 68 + kc + 4);
        *(uint4*)(Wt + (size_t)(n0 + nl) * K + k0 + kc) = make_uint4(a.x, a.y, b.x, b.y);
      }
    }
    __syncthreads();
  }
}

DI void s5_mats(const Params& p, float* sm) {
  float* pw_re = sm; float* pw_im = sm + 576; float* cf_re = sm + 1152; float* cf_im = sm + 1216;
  float* bb_re = sm + 1280; float* bb_im = sm + 2304; float* cc_re = sm + 3328; float* cc_im = sm + 4352; float* kt = sm + 5376;
  const int tid = otid();
  for (int task = blockIdx.x; task < 128; task += gridDim.x) {
    const int j = task >> 6, g = task & 63, jg = j * 64 + g;
    char* matb = p.ws + W_S5MAT + (size_t)j * S5MAT_STRIDE;
    bf16_t* wcat = (bf16_t*)(matb + S5_WCAT) + (size_t)g * 128 * 256;
    bf16_t* wst = (bf16_t*)(matb + S5_WST) + (size_t)g * 128 * 128;
    float* ap8 = (float*)(matb + S5_AP8) + (size_t)g * 128;
    if (tid < 64) {
      const float dt = expf(p.in[14][jg]);
      const float are = p.in[12][jg * 64 + tid], aim = p.in[13][jg * 64 + tid];
      const float x = are * dt, y = aim * dt;
      for (int m = 0; m <= 8; ++m) { float s, c; sincosf(y * (float)m, &s, &c); const float mag = expf(x * (float)m); pw_re[m * 64 + tid] = mag * c; pw_im[m * 64 + tid] = mag * s; }
      float s, c; sincosf(y, &s, &c); const float sh = sinf(0.5f * y); const float em1 = expm1f(x);
      const float nr = em1 * c - 2.0f * sh * sh, ni = (em1 + 1.0f) * s;
      const float den = are * are + aim * aim;
      cf_re[tid] = (nr * are + ni * aim) / den; cf_im[tid] = (ni * are - nr * aim) / den;
      ap8[tid * 2] = pw_re[8 * 64 + tid]; ap8[tid * 2 + 1] = pw_im[8 * 64 + tid];
    }
    __syncthreads();
    for (int e = tid; e < 1024; e += 256) {
      const int pp = e >> 4;
      const float br = p.in[15][(size_t)jg * 1024 + e], bi = p.in[16][(size_t)jg * 1024 + e];
      bb_re[e] = cf_re[pp] * br - cf_im[pp] * bi; bb_im[e] = cf_re[pp] * bi + cf_im[pp] * br;
      cc_re[e] = p.in[17][(size_t)jg * 1024 + e]; cc_im[e] = p.in[18][(size_t)jg * 1024 + e];
    }
    __syncthreads();
    for (int e = tid; e < 2048; e += 256) {
      const int m = e >> 8, c = (e >> 4) & 15, ch = e & 15;
      float acc = 0.f;
      for (int pp = 0; pp < 64; ++pp) {
        const float cr = cc_re[c * 64 + pp], ci = cc_im[c * 64 + pp], wr_ = pw_re[m * 64 + pp], wi = pw_im[m * 64 + pp];
        const float tr = cr * wr_ - ci * wi, ti = cr * wi + ci * wr_;
        acc += tr * bb_re[pp * 16 + ch] - ti * bb_im[pp * 16 + ch];
      }
      kt[e] = acc;
    }
    __syncthreads();
    for (int e = tid; e < 16384; e += 256) {
      const int pq = e >> 7, k = e & 127, s = k >> 4, ch = k & 15, pp = pq & 63, m = 7 - s;
      const float wr_ = pw_re[m * 64 + pp], wi = pw_im[m * 64 + pp], br = bb_re[pp * 16 + ch], bi = bb_im[pp * 16 + ch];
      wst[e] = f2bf(pq < 64 ? (wr_ * br - wi * bi) : (wr_ * bi + wi * br));
    }
    for (int e = tid; e < 32768; e += 256) {
      const int n = e >> 8, k = e & 255, t = n >> 4, c = n & 15;
      float val;
      if (k < 128) { const int s = k >> 4, ch = k & 15; val = (s <= t) ? kt[(t - s) * 256 + c * 16 + ch] : 0.f; }
      else { const int pq = k - 128, pp = pq & 63; const float cr = cc_re[c * 64 + pp], ci = cc_im[c * 64 + pp], wr_ = pw_re[(t + 1) * 64 + pp], wi = pw_im[(t + 1) * 64 + pp];
             val = pq < 64 ? (cr * wr_ - ci * wi) : -(cr * wi + ci * wr_); }
      wcat[e] = f2bf(val);
    }
    __syncthreads();
  }
}

template <int MODE>
DI void norm_phase(const Params& p, const float* __restrict__ gain, bool first, bf16_t* __restrict__ dst) {
  float* __restrict__ H = (float*)(p.ws + W_H);
  const int lane = otid() & 63, wid = otid() >> 6;
  for (int row0 = (blockIdx.x * 4 + wid) * 2; row0 < MT; row0 += gridDim.x * 8) {
    float4 v[2][4]; float ss[2] = {0.f, 0.f};
#pragma unroll
    for (int u = 0; u < 2; ++u) {
      const int row = row0 + u;
      const float* src = first ? (row < NP ? p.in[0] + (size_t)row * 1024 : p.in[1] + (size_t)(row - NP) * 1024) : H + (size_t)row * 1024;
#pragma unroll
      for (int i = 0; i < 4; ++i) v[u][i] = ((const float4*)src)[lane + 64 * i];
    }
#pragma unroll
    for (int u = 0; u < 2; ++u) {
#pragma unroll
      for (int i = 0; i < 4; ++i) ss[u] += v[u][i].x * v[u][i].x + v[u][i].y * v[u][i].y + v[u][i].z * v[u][i].z + v[u][i].w * v[u][i].w;
      ss[u] = wave_sum(ss[u]);
    }
#pragma unroll
    for (int u = 0; u < 2; ++u) {
      const int row = row0 + u;
      const float rstd = rsqrtf(ss[u] * (1.0f / 1024.0f) + 1e-6f);
      if (first) {
#pragma unroll
        for (int i = 0; i < 4; ++i) ((float4*)(H + (size_t)row * 1024))[lane + 64 * i] = v[u][i];
      }
#pragma unroll
      for (int i = 0; i < 4; ++i) {
        const int c = (lane + 64 * i) * 4;
        const float4 g4 = *(const float4*)(gain + c);
        const float y0 = v[u][i].x * rstd * g4.x, y1 = v[u][i].y * rstd * g4.y, y2 = v[u][i].z * rstd * g4.z, y3 = v[u][i].w * rstd * g4.w;
        if (MODE == 0) { uint2 w; w.x = pack2(y0, y1); w.y = pack2(y2, y3); *(uint2*)(dst + (size_t)row * 1024 + c) = w; }
        else if (MODE == 1) { const int g = c >> 4, ch = c & 15, r = row >> 3, t = row & 7; uint2 w; w.x = pack2(y0, y1); w.y = pack2(y2, y3);
                              *(uint2*)(dst + ((size_t)g * NR + r) * 256 + t * 16 + ch) = w; }
        else { float* o = row < NP ? p.out + O_YP + (size_t)row * 1024 + c : p.out + O_YS + (size_t)(row - NP) * 1024 + c; *(float4*)o = make_float4(y0, y1, y2, y3); }
      }
    }
  }
}

DI void s5_carry(const Params& p, int j) {
  const char* matb = p.ws + W_S5MAT + (size_t)j * S5MAT_STRIDE;
  const float* ap8 = (const float*)(matb + S5_AP8);
  bf16_t* up = (bf16_t*)(p.ws + W_SB + SC_UP);
  const float* sloc = (const float*)(p.ws + W_SB + SC_SLOC);
  const int gt = blockIdx.x * 256 + otid(), nth = gridDim.x * 256;
  for (int idx = gt; idx < 32768; idx += nth) {
    const int b = idx >> 12, g = (idx >> 6) & 63, pp = idx & 63;
    const float ar = ap8[(g * 64 + pp) * 2], ai = ap8[(g * 64 + pp) * 2 + 1];
    float sr = 0.f, si = 0.f;
    for (int c0 = 0; c0 < 256; c0 += 16) {
      float lr_[16], li_[16];
#pragma unroll
      for (int u = 0; u < 16; ++u) { const size_t r = (size_t)b * 256 + c0 + u; lr_[u] = sloc[(r * 64 + g) * 128 + pp]; li_[u] = sloc[(r * 64 + g) * 128 + 64 + pp]; }
#pragma unroll
      for (int u = 0; u < 16; ++u) {
        const size_t r = (size_t)b * 256 + c0 + u;
        bf16_t* d = up + ((size_t)g * NR + r) * 256 + 128 + pp; d[0] = f2bf(sr); d[64] = f2bf(si);
        const float nr = ar * sr - ai * si + lr_[u], ni = ar * si + ai * sr + li_[u]; sr = nr; si = ni;
      }
    }
    p.out[O_S5RP + ((size_t)(j * 8 + b) * 64 + g) * 64 + pp] = sr;
    p.out[O_S5IP + ((size_t)(j * 8 + b) * 64 + g) * 64 + pp] = si;
  }
  for (int idx = gt; idx < 524288; idx += nth) {
    const int b = idx >> 12, g = (idx >> 6) & 63, pp = idx & 63;
    const float ar = ap8[(g * 64 + pp) * 2], ai = ap8[(g * 64 + pp) * 2 + 1];
    const size_t si_ = ((size_t)(j * 128 + b) * 64 + g) * 64 + pp;
    const float sr = p.in[2][si_], si = p.in[3][si_];
    const size_t r = 2048 + b;
    bf16_t* d = up + ((size_t)g * NR + r) * 256 + 128 + pp; d[0] = f2bf(sr); d[64] = f2bf(si);
    p.out[O_S5RS + si_] = ar * sr - ai * si + sloc[(r * 64 + g) * 128 + pp];
    p.out[O_S5IS + si_] = ar * si + ai * sr + sloc[(r * 64 + g) * 128 + 64 + pp];
  }
}

DI float gla_logdecay(const float* __restrict__ gl, const float (&wg)[16], float bias) {
  const float4 a = *(const float4*)gl, b = *(const float4*)(gl + 4), c = *(const float4*)(gl + 8), d = *(const float4*)(gl + 12);
  float x = bias;
  x += a.x * wg[0] + a.y * wg[1] + a.z * wg[2] + a.w * wg[3];
  x += b.x * wg[4] + b.y * wg[5] + b.z * wg[6] + b.w * wg[7];
  x += c.x * wg[8] + c.y * wg[9] + c.z * wg[10] + c.w * wg[11];
  x += d.x * wg[12] + d.y * wg[13] + d.z * wg[14] + d.w * wg[15];
  return -softplusf_(-x) * (1.0f / 16.0f);
}
DI void gla_prep_body(const bf16_t* __restrict__ P, const float* __restrict__ GL, const float* __restrict__ wgu, const float* __restrict__ bgate,
                      bf16_t* __restrict__ QT, bf16_t* __restrict__ KTL, bf16_t* __restrict__ KDT, float* __restrict__ DL, float* gls) {
  const int tid = otid(), kch = tid & 127, sub = tid >> 7, kp = swap23(kch);
  for (int it2 = blockIdx.x; it2 < 512; it2 += gridDim.x) {
    const int item = it2 * 2 + sub, b = item >> 7, h = (item >> 5) & 3, c = item & 31, tokc = b * 2048 + c * 64;
    { const float4* src = (const float4*)(GL + (size_t)tokc * 16); float4* d = (float4*)(gls + sub * 1024);
      d[kch] = src[kch]; d[kch + 128] = src[kch + 128]; }
    float wg[16];
#pragma unroll
    for (int r = 0; r < 16; ++r) wg[r] = wgu[r * 512 + h * 128 + kch];
    const float bias = bgate[h * 128 + kch];
    __syncthreads();
    float cum = 0.f;
#pragma unroll 8
    for (int t = 0; t < 64; ++t) {
      cum += gla_logdecay(gls + sub * 1024 + t * 16, wg, bias);
      const float qv = bf2f(P[(size_t)(tokc + t) * 3072 + h * 128 + kch]) * 0.08838834764831845f;
      const float kv = bf2f(P[(size_t)(tokc + t) * 3072 + 512 + h * 128 + kch]);
      const bf16_t kt = f2bf(kv * expf(-cum));
      QT[(size_t)(tokc + t) * 512 + h * 128 + kp] = f2bf(qv * expf(cum));
      KTL[(size_t)(tokc + t) * 512 + h * 128 + kp] = kt;
      KDT[((size_t)item * 128 + kch) * 64 + swap23(t)] = kt;
    }
    DL[(size_t)item * 128 + kch] = expf(cum);
    __syncthreads();
  }
}
DI void gla_prep(const Params& p, float* sm) {
  gla_prep_body((const bf16_t*)(p.ws + W_SB + SC_GLA_P), (const float*)(p.ws + W_SB + SC_GLA_GL), p.in[22], p.in[23],
                (bf16_t*)(p.ws + W_SB + SC_GLA_QT), (bf16_t*)(p.ws + W_SB + SC_GLA_KTL), (bf16_t*)(p.ws + W_SB + SC_GLA_KDT), (float*)(p.ws + W_SB + SC_GLA_DL), sm);
}
struct EpiGlaQK { bf16_t* A; int itemb;
  DI void one(int row, int col, float v) const {
    if ((row >> 6) != (col >> 6)) return;
    const int t = row & 63, s_ = col & 63;
    A[((size_t)(itemb + (row >> 6)) * 64 + t) * 64 + swap23(s_)] = (s_ <= t) ? f2bf(v) : (bf16_t)0;
  }
  DI void operator()(int row, int col, float v0, float v1) const { one(row, col, v0); one(row, col + 32, v1); } };
DI void gla_aqk(const Params& p, bf16_t* smem) {
  const bf16_t* QT = (const bf16_t*)(p.ws + W_SB + SC_GLA_QT); const bf16_t* KTL = (const bf16_t*)(p.ws + W_SB + SC_GLA_KTL);
  bf16_t* AQ = (bf16_t*)(p.ws + W_SB + SC_GLA_AQK);
  for (int t = blockIdx.x; t < 512; t += gridDim.x) {
    const int b = t >> 6, h = (t >> 4) & 3, cp = t & 15, tok0 = b * 2048 + cp * 128;
    EpiGlaQK e{AQ, (b * 4 + h) * 32 + cp * 2};
    gemm_tile(QT + (size_t)tok0 * 512 + h * 128, 512, KTL + (size_t)tok0 * 512 + h * 128, 512, 128, e, smem);
  }
}

DI void gla_rec(const Params& p, float* sm) {
  const bf16_t* P = (const bf16_t*)(p.ws + W_SB + SC_GLA_P);
  const float* GL = (const float*)(p.ws + W_SB + SC_GLA_GL);
  float* O = (float*)(p.ws + W_SB + SC_GLA_O);
  const int tid = otid(), lane = tid & 63;
  const int nseq = 64;
  const bool split = (int)gridDim.x > nseq;
  if (!split || (int)blockIdx.x < nseq) {
    const bf16_t* QT = (const bf16_t*)(p.ws + W_SB + SC_GLA_QT); const bf16_t* KDT = (const bf16_t*)(p.ws + W_SB + SC_GLA_KDT);
    const float* DL = (const float*)(p.ws + W_SB + SC_GLA_DL); const bf16_t* AQ = (const bf16_t*)(p.ws + W_SB + SC_GLA_AQK);
    const int w = tid >> 6, r = lane & 31, hh = lane >> 5;
    for (int blk = blockIdx.x; blk < nseq; blk += gridDim.x) {
      const int bh = blk >> 1, b = bh >> 2, h = bh & 3, v0 = (blk & 1) * 128 + w * 32;
      f32x16 S[4];
#pragma unroll
      for (int i = 0; i < 4; ++i)
#pragma unroll
        for (int q = 0; q < 16; ++q) S[i][q] = 0.f;
      const int r16 = tid >> 4, c16 = (tid & 15) * 8, r8 = tid >> 3, c8 = (tid & 7) * 8;
      uint4 gq0, gq1, gq2, gq3, ga0, ga1, gk0, gk1, gk2, gk3; float gdl;
      { const bf16_t* qG = QT + (size_t)(b * 2048) * 512 + h * 128; const bf16_t* aG = AQ + (size_t)(bh * 32) * 4096; const bf16_t* kdG = KDT + (size_t)(bh * 32) * 8192;
        gq0 = *(const uint4*)(qG + (size_t)(r16 + 0) * 512 + c16);
        gq1 = *(const uint4*)(qG + (size_t)(r16 + 16) * 512 + c16);
        gq2 = *(const uint4*)(qG + (size_t)(r16 + 32) * 512 + c16);
        gq3 = *(const uint4*)(qG + (size_t)(r16 + 48) * 512 + c16);
        ga0 = *(const uint4*)(aG + (r8 + 0) * 64 + c8);
        ga1 = *(const uint4*)(aG + (r8 + 32) * 64 + c8);
        gk0 = *(const uint4*)(kdG + (r8 + 0) * 64 + c8);
        gk1 = *(const uint4*)(kdG + (r8 + 32) * 64 + c8);
        gk2 = *(const uint4*)(kdG + (r8 + 64) * 64 + c8);
        gk3 = *(const uint4*)(kdG + (r8 + 96) * 64 + c8);
        gdl = (tid < 128) ? DL[(size_t)(bh * 32) * 128 + tid] : 0.f; }
      for (int c = 0; c < 32; ++c) {
        const int item = bh * 32 + c, tokc = b * 2048 + c * 64;
        float* dl = sm + 11264 + (c & 1) * 128;
        bf16_t* qS = (bf16_t*)sm; bf16_t* aS = qS + 64 * 136; bf16_t* kdS = aS + 64 * 72;
        if (tid < 128) dl[tid] = gdl;
        *(uint4*)(qS + (r16 + 0) * 136 + c16) = gq0;
        *(uint4*)(qS + (r16 + 16) * 136 + c16) = gq1;
        *(uint4*)(qS + (r16 + 32) * 136 + c16) = gq2;
        *(uint4*)(qS + (r16 + 48) * 136 + c16) = gq3;
        *(uint4*)(aS + (r8 + 0) * 72 + c8) = ga0;
        *(uint4*)(aS + (r8 + 32) * 72 + c8) = ga1;
        *(uint4*)(kdS + (r8 + 0) * 72 + c8) = gk0;
        *(uint4*)(kdS + (r8 + 32) * 72 + c8) = gk1;
        *(uint4*)(kdS + (r8 + 64) * 72 + c8) = gk2;
        *(uint4*)(kdS + (r8 + 96) * 72 + c8) = gk3;
        __syncthreads();
        if (c + 1 < 32) {
          { const bf16_t* qG = QT + (size_t)(tokc + 64) * 512 + h * 128; const bf16_t* aG = AQ + (size_t)(item + 1) * 4096; const bf16_t* kdG = KDT + (size_t)(item + 1) * 8192;
            gq0 = *(const uint4*)(qG + (size_t)(r16 + 0) * 512 + c16);
            gq1 = *(const uint4*)(qG + (size_t)(r16 + 16) * 512 + c16);
            gq2 = *(const uint4*)(qG + (size_t)(r16 + 32) * 512 + c16);
            gq3 = *(const uint4*)(qG + (size_t)(r16 + 48) * 512 + c16);
            ga0 = *(const uint4*)(aG + (r8 + 0) * 64 + c8);
            ga1 = *(const uint4*)(aG + (r8 + 32) * 64 + c8);
            gk0 = *(const uint4*)(kdG + (r8 + 0) * 64 + c8);
            gk1 = *(const uint4*)(kdG + (r8 + 32) * 64 + c8);
            gk2 = *(const uint4*)(kdG + (r8 + 64) * 64 + c8);
            gk3 = *(const uint4*)(kdG + (r8 + 96) * 64 + c8);
            gdl = (tid < 128) ? DL[(size_t)(item + 1) * 128 + tid] : 0.f; }
        }
        const bf16_t* qA = qS + r * 136 + 8 * hh;
        const bf16_t* aA = aS + r * 72 + 8 * hh;
        const bf16_t* kdA = kdS + r * 72 + 8 * hh;
        const bf16_t* vP = P + (size_t)tokc * 3072 + 1024 + h * 256 + v0 + r;
        bf16x8 sf[8];
        sf[0] = pack8<0>(S[0]); sf[1] = pack8<1>(S[0]); sf[2] = pack8<0>(S[1]); sf[3] = pack8<1>(S[1]);
        sf[4] = pack8<0>(S[2]); sf[5] = pack8<1>(S[2]); sf[6] = pack8<0>(S[3]); sf[7] = pack8<1>(S[3]);
        bf16x8 vf[4];
        const bf16_t* vrun = vP + (size_t)(4 * hh) * 3072;
#pragma unroll
        for (int f = 0; f < 4; ++f) {
#pragma unroll
          for (int j = 0; j < 8; ++j) vf[f][j] = (short)vrun[(size_t)((j & 3) + 8 * (j >> 2)) * 3072];
          vrun += (size_t)16 * 3072; asm volatile("" : "+v"(vrun));
        }
#pragma unroll
        for (int i = 0; i < 2; ++i) {
          f32x16 Oq;
#pragma unroll
          for (int q = 0; q < 16; ++q) Oq[q] = 0.f;
#pragma unroll
          for (int ks = 0; ks < 8; ++ks) {
            const bf16x8 qa = *(const bf16x8*)(qA + (32 * i) * 136 + ks * 16);
            Oq = __builtin_amdgcn_mfma_f32_32x32x16_bf16(qa, sf[ks], Oq, 0, 0, 0);
          }
#pragma unroll
          for (int ks = 0; ks < 4; ++ks) {
            const bf16x8 aa = *(const bf16x8*)(aA + (32 * i) * 72 + ks * 16);
            Oq = __builtin_amdgcn_mfma_f32_32x32x16_bf16(aa, vf[ks], Oq, 0, 0, 0);
          }
          {
            float* orun = O + (size_t)(tokc + 32 * i + 4 * hh) * 1024 + h * 256 + v0 + r;
#pragma unroll
            for (int q4 = 0; q4 < 4; ++q4) {
#pragma unroll
              for (int u = 0; u < 4; ++u) orun[(size_t)u * 1024] = Oq[q4 * 4 + u];
              orun += (size_t)8 * 1024; asm volatile("" : "+v"(orun));
            }
          }
        }
#pragma unroll
        for (int i = 0; i < 4; ++i) {
#pragma unroll
          for (int ks = 0; ks < 4; ++ks) {
            const bf16x8 ka = *(const bf16x8*)(kdA + (32 * i) * 72 + ks * 16);
            S[i] = __builtin_amdgcn_mfma_f32_32x32x16_bf16(ka, vf[ks], S[i], 0, 0, 0);
          }
#pragma unroll
          for (int q4 = 0; q4 < 4; ++q4) {
            const float4 d4 = *(const float4*)(dl + 32 * i + 8 * q4 + 4 * hh);
            S[i][q4 * 4 + 0] *= d4.x; S[i][q4 * 4 + 1] *= d4.y; S[i][q4 * 4 + 2] *= d4.z; S[i][q4 * 4 + 3] *= d4.w;
          }
        }
        __syncthreads();
      }
      float* so = p.out + O_GLAP + ((size_t)bh * 128) * 256 + v0 + r;
#pragma unroll
      for (int i = 0; i < 4; ++i)
#pragma unroll
        for (int q = 0; q < 16; ++q) so[(size_t)(32 * i + crow(q, hh)) * 256] = S[i][q];
      __syncthreads();
    }
  }
  if (!split || (int)blockIdx.x >= nseq) {
    const int first = split ? (int)blockIdx.x - nseq : (int)blockIdx.x, nb = split ? (int)gridDim.x - nseq : (int)gridDim.x;
    for (int item = first; item < 512; item += nb) {
      const int b = item >> 2, h = item & 3;
      const int L = 8, tok0 = NP + b * 8;
      float S[128];
      { const float* s0 = p.in[4] + ((size_t)(b * 4 + h) * 128) * 256 + tid;
#pragma unroll
        for (int k = 0; k < 128; ++k) S[k] = s0[(size_t)k * 256]; }
      float nd = 0.f, nq = 0.f, nkv = 0.f, nv;
      float wg[16]; float gbias = 0.f;
      if (tid < 128) {
#pragma unroll
        for (int r = 0; r < 16; ++r) wg[r] = p.in[22][r * 512 + h * 128 + tid];
        gbias = p.in[23][h * 128 + tid];
      } else {
#pragma unroll
        for (int r = 0; r < 16; ++r) wg[r] = 0.f;
      }
      {
        const size_t tok = tok0;
        if (tid < 128) { nd = expf(gla_logdecay(GL + tok * 16, wg, gbias)); nq = bf2f(P[tok * 3072 + h * 128 + tid]) * 0.08838834764831845f; nkv = bf2f(P[tok * 3072 + 512 + h * 128 + tid]); }
        nv = bf2f(P[tok * 3072 + 1024 + h * 256 + tid]);
      }
      for (int t = 0; t < L; ++t) {
        float* bb = sm + (t & 1) * 384;
        if (tid < 128) { bb[tid] = nd; bb[128 + tid] = nq; bb[256 + tid] = nkv; }
        const float vv = nv;
        __syncthreads();
        if (t + 1 < L) {
          const size_t tok = tok0 + t + 1;
          if (tid < 128) { nd = expf(gla_logdecay(GL + tok * 16, wg, gbias)); nq = bf2f(P[tok * 3072 + h * 128 + tid]) * 0.08838834764831845f; nkv = bf2f(P[tok * 3072 + 512 + h * 128 + tid]); }
          nv = bf2f(P[tok * 3072 + 1024 + h * 256 + tid]);
        }
        float o = 0.f;
#pragma unroll
        for (int c = 0; c < 8; ++c) {
#pragma unroll
          for (int k = c * 16; k < c * 16 + 16; ++k) { S[k] = bb[k] * S[k] + bb[256 + k] * vv; o += bb[128 + k] * S[k]; }
          __builtin_amdgcn_sched_barrier(0);
        }
        O[(size_t)(tok0 + t) * 1024 + h * 256 + tid] = o;
      }
      float* so = p.out + O_GLAS + ((size_t)(b * 4 + h) * 128) * 256 + tid;
#pragma unroll
      for (int k = 0; k < 128; ++k) so[(size_t)k * 256] = S[k];
      __syncthreads();
    }
  }
}

DI void gla_headnorm_body(const bf16_t* __restrict__ P, const float* __restrict__ O, bf16_t* __restrict__ OG, const float* __restrict__ gain) {
  const int lane = otid() & 63, wid = otid() >> 6;
  const float4 g4 = *(const float4*)(gain + lane * 4);
  for (int it0 = (blockIdx.x * 4 + wid) * 2; it0 < MT * 4; it0 += gridDim.x * 8) {
    float4 o[2]; uint2 rr[2];
#pragma unroll
    for (int u = 0; u < 2; ++u) { const int tok = (it0 + u) >> 2, h = (it0 + u) & 3;
      o[u] = *(const float4*)(O + (size_t)tok * 1024 + h * 256 + lane * 4); rr[u] = *(const uint2*)(P + (size_t)tok * 3072 + 2048 + h * 256 + lane * 4); }
#pragma unroll
    for (int u = 0; u < 2; ++u) { const int tok = (it0 + u) >> 2, h = (it0 + u) & 3;
      const float ss = wave_sum(o[u].x * o[u].x + o[u].y * o[u].y + o[u].z * o[u].z + o[u].w * o[u].w);
      const float rstd = rsqrtf(ss * (1.0f / 256.0f) + 1e-6f);
      const float r0 = __uint_as_float(rr[u].x << 16), r1 = __uint_as_float(rr[u].x & 0xffff0000u), r2 = __uint_as_float(rr[u].y << 16), r3 = __uint_as_float(rr[u].y & 0xffff0000u);
      uint2 w;
      w.x = pack2(o[u].x * rstd * g4.x * r0 * sigmoidf_(r0), o[u].y * rstd * g4.y * r1 * sigmoidf_(r1));
      w.y = pack2(o[u].z * rstd * g4.z * r2 * sigmoidf_(r2), o[u].w * rstd * g4.w * r3 * sigmoidf_(r3));
      *(uint2*)(OG + (size_t)tok * 1024 + h * 256 + lane * 4) = w; }
  }
}
DI void gla_headnorm(const Params& p) {
  gla_headnorm_body((const bf16_t*)(p.ws + W_SB + SC_GLA_P), (const float*)(p.ws + W_SB + SC_GLA_O), (bf16_t*)(p.ws + W_SB + SC_HN), p.in[24]);
}

DI void gdn_conv_body(const bf16_t* __restrict__ PRE, bf16_t* __restrict__ QKV, bf16_t* __restrict__ KT, const float* __restrict__ conv0,
                      const float* __restrict__ convw) {
  const int tid = otid(), c0 = tid * 16;
  float cw[4][16];
#pragma unroll
  for (int j = 0; j < 4; ++j)
#pragma unroll
    for (int i = 0; i < 16; ++i) cw[j][i] = convw[j * 4096 + c0 + i];
  for (int run = blockIdx.x; run < MT / 34; run += gridDim.x) {
    float x0[16], x1[16], x2[16];
    uint4 na, nb;
    { const uint4* src = (const uint4*)(PRE + (size_t)(run * 34) * 4096 + c0); na = src[0]; nb = src[1]; }
    for (int i = 0; i < 34; ++i) {
      const int tok = run * 34 + i;
      const int trunk = tok >= NP;
      const int b = trunk ? (tok - NP) >> 3 : tok >> 11, l = trunk ? (tok - NP) & 7 : tok & 2047;
      if (l == 0) {
        if (trunk) { const float* c = conv0 + (size_t)b * 3 * 4096 + c0;
#pragma unroll
          for (int q = 0; q < 16; ++q) { x0[q] = c[q]; x1[q] = c[4096 + q]; x2[q] = c[8192 + q]; } }
        else {
#pragma unroll
          for (int q = 0; q < 16; ++q) { x0[q] = 0.f; x1[q] = 0.f; x2[q] = 0.f; } }
      } else if (i == 0) {
#pragma unroll
        for (int jj = 0; jj < 3; ++jj) {
          const int lp = l - 3 + jj;
          float xr[16];
          if (lp >= 0) {
            const uint4* sp = (const uint4*)(PRE + (size_t)(tok - 3 + jj) * 4096 + c0);
            const uint4 a = sp[0], b2 = sp[1];
            const unsigned w[8] = {a.x, a.y, a.z, a.w, b2.x, b2.y, b2.z, b2.w};
#pragma unroll
            for (int q = 0; q < 8; ++q) { xr[2 * q] = __uint_as_float(w[q] << 16); xr[2 * q + 1] = __uint_as_float(w[q] & 0xffff0000u); }
          } else if (trunk) {
            const float* c = conv0 + ((size_t)b * 3 + (lp + 3)) * 4096 + c0;
#pragma unroll
            for (int q = 0; q < 16; ++q) xr[q] = c[q];
          } else {
#pragma unroll
            for (int q = 0; q < 16; ++q) xr[q] = 0.f;
          }
#pragma unroll
          for (int q = 0; q < 16; ++q) { if (jj == 0) x0[q] = xr[q]; else if (jj == 1) x1[q] = xr[q]; else x2[q] = xr[q]; }
        }
      }
      const unsigned wc[8] = {na.x, na.y, na.z, na.w, nb.x, nb.y, nb.z, nb.w};
      if (i + 1 < 34) { const uint4* src = (const uint4*)(PRE + (size_t)(tok + 1) * 4096 + c0); na = src[0]; nb = src[1]; }
      float cur[16], acc[16];
#pragma unroll
      for (int q = 0; q < 8; ++q) { cur[2 * q] = __uint_as_float(wc[q] << 16); cur[2 * q + 1] = __uint_as_float(wc[q] & 0xffff0000u); }
      float ss = 0.f;
#pragma unroll
      for (int q = 0; q < 16; ++q) {
        float a = x0[q] * cw[0][q] + x1[q] * cw[1][q] + x2[q] * cw[2][q] + cur[q] * cw[3][q];
        a = a * sigmoidf_(a); acc[q] = a; ss += a * a;
        x0[q] = x1[q]; x1[q] = x2[q]; x2[q] = cur[q];
      }
      ss += __shfl_xor(ss, 1); ss += __shfl_xor(ss, 2); ss += __shfl_xor(ss, 4);
      float sc = 1.0f;
      if (tid < 128) { sc = rsqrtf(ss + 1e-6f); if (tid < 64) sc *= 0.08838834764831845f; }
      float ov[16];
#pragma unroll
      for (int q = 0; q < 16; ++q) ov[q] = acc[q] * sc;
      if (!trunk && tid >= 64 && tid < 128) {
        const int kc = c0 - 1024, hq = kc >> 7, kch0 = kc & 127, chunk = l >> 6, tl = swap23(l & 63);
        bf16_t* kt = KT + ((size_t)((b * 8 + hq) * 32 + chunk) * 128 + kch0) * 64 + tl;
#pragma unroll
        for (int q = 0; q < 16; ++q) kt[q * 64] = f2bf(ov[q]);
      }
      if (tid < 128) {
#pragma unroll
        for (int q = 0; q < 16; ++q) if ((q & 4) && !(q & 8)) { const float tmp = ov[q]; ov[q] = ov[q + 4]; ov[q + 4] = tmp; }
      }
      uint4 o0, o1;
      o0.x = pack2(ov[0], ov[1]); o0.y = pack2(ov[2], ov[3]); o0.z = pack2(ov[4], ov[5]); o0.w = pack2(ov[6], ov[7]);
      o1.x = pack2(ov[8], ov[9]); o1.y = pack2(ov[10], ov[11]); o1.z = pack2(ov[12], ov[13]); o1.w = pack2(ov[14], ov[15]);
      uint4* dst = (uint4*)(QKV + (size_t)tok * 4096 + c0); dst[0] = o0; dst[1] = o1;
    }
  }
}
DI void gdn_gates_body(const float* __restrict__ BAr, float* __restrict__ GATES, const float* __restrict__ a_log, const float* __restrict__ dt_bias) {
  const int tid = otid(), lane = tid & 63, wid = tid >> 6;
  for (int it = blockIdx.x * 4 + wid; it < 4096; it += gridDim.x * 4) {
    const int h = it & 15, bc = it >> 4;
    const size_t tok = (size_t)bc * 64 + lane;
    const float beta = sigmoidf_(BAr[tok * 32 + h]);
    const float g = -expf(a_log[h]) * softplusf_(BAr[tok * 32 + 16 + h] + dt_bias[h]);
    float cum = g;
#pragma unroll
    for (int o = 1; o < 64; o <<= 1) { const float up = __shfl_up(cum, o); if (lane >= o) cum += up; }
    GATES[tok * 48 + h] = beta; GATES[tok * 48 + 16 + h] = g; GATES[tok * 48 + 32 + h] = cum;
  }
  const int gt = blockIdx.x * 256 + tid, nth = gridDim.x * 256;
  for (int idx = gt; idx < 1024 * 16; idx += nth) {
    const int h = idx & 15; const size_t tok = NP + (idx >> 4);
    GATES[tok * 48 + h] = sigmoidf_(BAr[tok * 32 + h]);
    GATES[tok * 48 + 16 + h] = -expf(a_log[h]) * softplusf_(BAr[tok * 32 + 16 + h] + dt_bias[h]);
  }
}
DI void gdn_conv(const Params& p) {
  gdn_conv_body((const bf16_t*)(p.ws + W_SB + SC_GDN_PRE), (bf16_t*)(p.ws + W_SB + SC_GDN_QKV), (bf16_t*)(p.ws + W_SB + SC_GDN_KT), p.in[6], p.in[27]);
  gdn_gates_body((const float*)(p.ws + W_SB + SC_GDN_BA), (float*)(p.ws + W_SB + SC_GDN_GATES), p.in[28], p.in[29]);
}

struct EpiKK { float* M; const float* GATES; int tok0, itemb, hq;
  DI void one(int row, int col, float v) const {
    if ((row >> 6) != (col >> 6)) return;
    const int t = row & 63, s_ = col & 63; if (s_ >= t) return;
    const float* gt_ = GATES + (size_t)(tok0 + row) * 48; const float* gs_ = GATES + (size_t)(tok0 + col) * 48;
#pragma unroll
    for (int hh = 0; hh < 2; ++hh) { const int h = hq * 2 + hh;
      M[((size_t)(itemb + h * 32 + (row >> 6)) * 64 + t) * 64 + s_] = gt_[h] * v * expf(gt_[32 + h] - gs_[32 + h]); }
  }
  DI void operator()(int row, int col, float v0, float v1) const { one(row, col, v0); one(row, col + 32, v1); } };
struct EpiQK { bf16_t* A; const float* GATES; int tok0, itemb, hq;
  DI void one(int row, int col, float v) const {
    if ((row >> 6) != (col >> 6)) return;
    const int t = row & 63, s_ = col & 63;
    const float* gt_ = GATES + (size_t)(tok0 + row) * 48; const float* gs_ = GATES + (size_t)(tok0 + col) * 48;
#pragma unroll
    for (int hh = 0; hh < 2; ++hh) { const int h = hq * 2 + hh;
      A[((size_t)(itemb + h * 32 + (row >> 6)) * 64 + t) * 64 + swap23(s_)] = (s_ <= t) ? f2bf(v * expf(gt_[32 + h] - gs_[32 + h])) : (bf16_t)0; }
  }
  DI void operator()(int row, int col, float v0, float v1) const { one(row, col, v0); one(row, col + 32, v1); } };

DI void gdn_kkqk(const Params& p, bf16_t* smem) {
  const bf16_t* QKV = (const bf16_t*)(p.ws + W_SB + SC_GDN_QKV);
  const float* GATES = (const float*)(p.ws + W_SB + SC_GDN_GATES);
  float* M = (float*)(p.ws + W_SB + SC_GDN_OM); bf16_t* AQ = (bf16_t*)(p.ws + W_SB + SC_GDN_AQK);
  for (int t = blockIdx.x; t < 1024; t += gridDim.x) {
    const int b = t >> 7, hq = (t >> 4) & 7, cp = t & 15, tok0 = b * 2048 + cp * 128;
    const bf16_t* kr = QKV + (size_t)tok0 * 4096 + 1024 + hq * 128; const bf16_t* qr = QKV + (size_t)tok0 * 4096 + hq * 128;
    EpiKK e1{M, GATES, tok0, b * 512 + cp * 2, hq};
    gemm_tile(kr, 4096, kr, 4096, 128, e1, smem);
    EpiQK e2{AQ, GATES, tok0, b * 512 + cp * 2, hq};
    gemm_tile(qr, 4096, kr, 4096, 128, e2, smem);
  }
}

DI void gdn_inverse(const Params& p, float* sm) {
  const float* M = (const float*)(p.ws + W_SB + SC_GDN_OM); bf16_t* TI = (bf16_t*)(p.ws + W_SB + SC_GDN_TINV);
  const int tid = otid(), lane = tid & 63, w = tid >> 6;
  float* Ms = sm + w * (64 * 68);
  const int nw = gridDim.x * 4;
  for (int base = 0; base < 4096; base += nw) {
    const int item = base + blockIdx.x * 4 + w;
    if (item < 4096) {
      const float* Mi = M + (size_t)item * 4096;
      for (int i = 1; i < 64; ++i) Ms[i * 68 + lane] = Mi[i * 64 + lane];
    }
    __syncthreads();
    if (item < 4096) {
      float x[64];
#pragma unroll
      for (int t = 0; t < 64; ++t) {
        float a = (t == lane) ? 1.0f : 0.0f;
#pragma unroll
        for (int s_ = 0; s_ < t; ++s_) a -= Ms[t * 68 + s_] * x[s_];
        x[t] = a;
      }
      bf16_t* To = TI + (size_t)item * 4096 + swap23(lane);
#pragma unroll
      for (int t = 0; t < 64; ++t) To[t * 64] = f2bf(x[t]);
    }
    __syncthreads();
  }
}

DI void gdn_rec(const Params& p, float* sm) {
  const bf16_t* QKV = (const bf16_t*)(p.ws + W_SB + SC_GDN_QKV);
  const float* GATES = (const float*)(p.ws + W_SB + SC_GDN_GATES);
  const bf16_t* TI = (const bf16_t*)(p.ws + W_SB + SC_GDN_TINV); const bf16_t* AQ = (const bf16_t*)(p.ws + W_SB + SC_GDN_AQK);
  const bf16_t* KT = (const bf16_t*)(p.ws + W_SB + SC_GDN_KT);
  bf16_t* O = (bf16_t*)(p.ws + W_SB + SC_GDN_OM);
  const int tid = otid(), lane = tid & 63;
  const int nseq = 128;
  const bool split = (int)gridDim.x > nseq;
  if (!split || (int)blockIdx.x < nseq) {
    const int w = tid >> 6, r = lane & 31, hh = lane >> 5, v0 = w * 32;
    for (int blk = blockIdx.x; blk < nseq; blk += gridDim.x) {
      const int b = blk >> 4, h = blk & 15, hq = h >> 1;
      f32x16 S[4];
#pragma unroll
      for (int i = 0; i < 4; ++i)
#pragma unroll
        for (int q = 0; q < 16; ++q) S[i][q] = 0.f;
      const int r16 = tid >> 4, c16 = (tid & 15) * 8, r8 = tid >> 3, c8 = (tid & 7) * 8;
      uint4 pt0, pt1, pa0, pa1, pk0, pk1, pk2, pk3;
      { const bf16_t* tG = TI + (size_t)(blk * 32) * 4096; const bf16_t* aG = AQ + (size_t)(blk * 32) * 4096; const bf16_t* ktG = KT + (size_t)((b * 8 + hq) * 32 + (0)) * 8192;
        pt0 = *(const uint4*)(tG + (r8 + 0) * 64 + c8); pa0 = *(const uint4*)(aG + (r8 + 0) * 64 + c8);
        pt1 = *(const uint4*)(tG + (r8 + 32) * 64 + c8); pa1 = *(const uint4*)(aG + (r8 + 32) * 64 + c8);
        pk0 = *(const uint4*)(ktG + (r8 + 0) * 64 + c8);
        pk1 = *(const uint4*)(ktG + (r8 + 32) * 64 + c8);
        pk2 = *(const uint4*)(ktG + (r8 + 64) * 64 + c8);
        pk3 = *(const uint4*)(ktG + (r8 + 96) * 64 + c8);
      }
      for (int c = 0; c < 32; ++c) {
        const int item = blk * 32 + c, tokc = b * 2048 + c * 64;
        float* bt = sm + 17920 + (c & 1) * 192; float* eg = bt + 64; float* dy = bt + 128;
        bf16_t* kS = (bf16_t*)sm; bf16_t* qS = kS + 64 * 136; bf16_t* tS = qS + 64 * 136; bf16_t* aS = tS + 64 * 72; bf16_t* ktS = aS + 64 * 72;
        {
          const bf16_t* kG = QKV + (size_t)tokc * 4096 + 1024 + hq * 128; const bf16_t* qG = QKV + (size_t)tokc * 4096 + hq * 128;
          uint4 gk[4], gq[4];
#pragma unroll
          for (int i = 0; i < 4; ++i) { gk[i] = *(const uint4*)(kG + (size_t)(r16 + 16 * i) * 4096 + c16); gq[i] = *(const uint4*)(qG + (size_t)(r16 + 16 * i) * 4096 + c16); }
          if (tid < 64) {
            const float* gp = GATES + (size_t)(tokc + tid) * 48;
            const float gc = gp[32 + h], gl = GATES[(size_t)(tokc + 63) * 48 + 32 + h];
            bt[tid] = gp[h]; eg[tid] = expf(gc); dy[tid] = expf(gl - gc);
          }
          *(uint4*)(tS + (r8 + 0) * 72 + c8) = pt0; *(uint4*)(tS + (r8 + 32) * 72 + c8) = pt1;
          *(uint4*)(aS + (r8 + 0) * 72 + c8) = pa0; *(uint4*)(aS + (r8 + 32) * 72 + c8) = pa1;
          *(uint4*)(ktS + (r8 + 0) * 72 + c8) = pk0; *(uint4*)(ktS + (r8 + 32) * 72 + c8) = pk1; *(uint4*)(ktS + (r8 + 64) * 72 + c8) = pk2; *(uint4*)(ktS + (r8 + 96) * 72 + c8) = pk3;
#pragma unroll
          for (int i = 0; i < 4; ++i) { *(uint4*)(kS + (r16 + 16 * i) * 136 + c16) = gk[i]; *(uint4*)(qS + (r16 + 16 * i) * 136 + c16) = gq[i]; }
        }
        __builtin_amdgcn_sched_barrier(0);
        __syncthreads();
        if (c + 1 < 32) {
          { const bf16_t* tG = TI + (size_t)(item + 1) * 4096; const bf16_t* aG = AQ + (size_t)(item + 1) * 4096; const bf16_t* ktG = KT + (size_t)((b * 8 + hq) * 32 + (c + 1)) * 8192;
            pt0 = *(const uint4*)(tG + (r8 + 0) * 64 + c8); pa0 = *(const uint4*)(aG + (r8 + 0) * 64 + c8);
            pt1 = *(const uint4*)(tG + (r8 + 32) * 64 + c8); pa1 = *(const uint4*)(aG + (r8 + 32) * 64 + c8);
            pk0 = *(const uint4*)(ktG + (r8 + 0) * 64 + c8);
            pk1 = *(const uint4*)(ktG + (r8 + 32) * 64 + c8);
            pk2 = *(const uint4*)(ktG + (r8 + 64) * 64 + c8);
            pk3 = *(const uint4*)(ktG + (r8 + 96) * 64 + c8);
          }
        }
        const bf16_t* kA = kS + r * 136 + 8 * hh;
        const bf16_t* qA = qS + r * 136 + 8 * hh;
        const bf16_t* tA = tS + r * 72 + 8 * hh;
        const bf16_t* aA = aS + r * 72 + 8 * hh;
        const bf16_t* ktA = ktS + r * 72 + 8 * hh;
        const bf16_t* vP = QKV + (size_t)tokc * 4096 + 2048 + h * 128 + v0 + r;
        f32x16 R[2];
        {
          bf16x8 sf[8];
          sf[0] = pack8<0>(S[0]); sf[1] = pack8<1>(S[0]); sf[2] = pack8<0>(S[1]); sf[3] = pack8<1>(S[1]);
          sf[4] = pack8<0>(S[2]); sf[5] = pack8<1>(S[2]); sf[6] = pack8<0>(S[3]); sf[7] = pack8<1>(S[3]);
#pragma unroll
          for (int i = 0; i < 2; ++i) {
#pragma unroll
            for (int q = 0; q < 16; ++q) R[i][q] = 0.f;
#pragma unroll
            for (int ks = 0; ks < 8; ++ks) {
              const bf16x8 ka = *(const bf16x8*)(kA + (32 * i) * 136 + ks * 16);
              R[i] = __builtin_amdgcn_mfma_f32_32x32x16_bf16(ka, sf[ks], R[i], 0, 0, 0);
            }
          }
        }
        __builtin_amdgcn_sched_barrier(0);
        const bf16_t* vrun = vP + (size_t)(4 * hh) * 4096;
#pragma unroll
        for (int i = 0; i < 2; ++i)
#pragma unroll
          for (int q4 = 0; q4 < 4; ++q4) {
            const float4 b4 = *(const float4*)(bt + 32 * i + 8 * q4 + 4 * hh); const float4 e4 = *(const float4*)(eg + 32 * i + 8 * q4 + 4 * hh);
            const float bb[4] = {b4.x, b4.y, b4.z, b4.w}, ee[4] = {e4.x, e4.y, e4.z, e4.w};
#pragma unroll
            for (int u = 0; u < 4; ++u) {
              const float vv = bf2f(vrun[(size_t)u * 4096]);
              R[i][q4 * 4 + u] = bb[u] * (vv - ee[u] * R[i][q4 * 4 + u]);
            }
            vrun += (size_t)8 * 4096; asm volatile("" : "+v"(vrun));
          }
        bf16x8 xf[4];
        xf[0] = pack8<0>(R[0]); xf[1] = pack8<1>(R[0]); xf[2] = pack8<0>(R[1]); xf[3] = pack8<1>(R[1]);
        f32x16 VN[2];
#pragma unroll
        for (int i = 0; i < 2; ++i) {
#pragma unroll
          for (int q = 0; q < 16; ++q) VN[i][q] = 0.f;
#pragma unroll
          for (int ks = 0; ks < 4; ++ks) {
            const bf16x8 ta = *(const bf16x8*)(tA + (32 * i) * 72 + ks * 16);
            VN[i] = __builtin_amdgcn_mfma_f32_32x32x16_bf16(ta, xf[ks], VN[i], 0, 0, 0);
          }
        }
        bf16x8 vf[4];
        vf[0] = pack8<0>(VN[0]); vf[1] = pack8<1>(VN[0]); vf[2] = pack8<0>(VN[1]); vf[3] = pack8<1>(VN[1]);
        __builtin_amdgcn_sched_barrier(0);
        f32x16 Oq[2];
        {
          bf16x8 sf[8];
          sf[0] = pack8<0>(S[0]); sf[1] = pack8<1>(S[0]); sf[2] = pack8<0>(S[1]); sf[3] = pack8<1>(S[1]);
          sf[4] = pack8<0>(S[2]); sf[5] = pack8<1>(S[2]); sf[6] = pack8<0>(S[3]); sf[7] = pack8<1>(S[3]);
#pragma unroll
          for (int i = 0; i < 2; ++i) {
#pragma unroll
            for (int q = 0; q < 16; ++q) Oq[i][q] = 0.f;
#pragma unroll
            for (int ks = 0; ks < 8; ++ks) {
              const bf16x8 qa = *(const bf16x8*)(qA + (32 * i) * 136 + ks * 16);
              Oq[i] = __builtin_amdgcn_mfma_f32_32x32x16_bf16(qa, sf[ks], Oq[i], 0, 0, 0);
            }
          }
        }
        __builtin_amdgcn_sched_barrier(0);
#pragma unroll
        for (int i = 0; i < 2; ++i) {
#pragma unroll
          for (int q4 = 0; q4 < 4; ++q4) {
            const float4 e4 = *(const float4*)(eg + 32 * i + 8 * q4 + 4 * hh);
            Oq[i][q4 * 4 + 0] *= e4.x; Oq[i][q4 * 4 + 1] *= e4.y; Oq[i][q4 * 4 + 2] *= e4.z; Oq[i][q4 * 4 + 3] *= e4.w;
          }
#pragma unroll
          for (int ks = 0; ks < 4; ++ks) {
            const bf16x8 aa = *(const bf16x8*)(aA + (32 * i) * 72 + ks * 16);
            Oq[i] = __builtin_amdgcn_mfma_f32_32x32x16_bf16(aa, vf[ks], Oq[i], 0, 0, 0);
          }
          {
            bf16_t* orun = O + (size_t)(tokc + 32 * i + 4 * hh) * 2048 + h * 128 + v0 + r;
#pragma unroll
            for (int q4 = 0; q4 < 4; ++q4) {
#pragma unroll
              for (int u = 0; u < 4; ++u) orun[(size_t)u * 2048] = f2bf(Oq[i][q4 * 4 + u]);
              orun += (size_t)8 * 2048; asm volatile("" : "+v"(orun));
            }
          }
        }
#pragma unroll
        for (int i = 0; i < 2; ++i)
#pragma unroll
          for (int q4 = 0; q4 < 4; ++q4) {
            const float4 d4 = *(const float4*)(dy + 32 * i + 8 * q4 + 4 * hh);
            VN[i][q4 * 4 + 0] *= d4.x; VN[i][q4 * 4 + 1] *= d4.y; VN[i][q4 * 4 + 2] *= d4.z; VN[i][q4 * 4 + 3] *= d4.w;
          }
        bf16x8 yf[4];
        yf[0] = pack8<0>(VN[0]); yf[1] = pack8<1>(VN[0]); yf[2] = pack8<0>(VN[1]); yf[3] = pack8<1>(VN[1]);
        const float egl = eg[63];
#pragma unroll
        for (int i = 0; i < 4; ++i) {
#pragma unroll
          for (int q = 0; q < 16; ++q) S[i][q] *= egl;
#pragma unroll
          for (int ks = 0; ks < 4; ++ks) {
            const bf16x8 ka = *(const bf16x8*)(ktA + (32 * i) * 72 + ks * 16);
            S[i] = __builtin_amdgcn_mfma_f32_32x32x16_bf16(ka, yf[ks], S[i], 0, 0, 0);
          }
        }
        __syncthreads();
      }
      float* so = p.out + O_GDNP + ((size_t)(b * 16 + h) * 128) * 128 + v0 + r;
#pragma unroll
      for (int i = 0; i < 4; ++i)
#pragma unroll
        for (int q = 0; q < 16; ++q) so[(size_t)(32 * i + crow(q, hh)) * 128] = S[i][q];
      __syncthreads();
    }
  }
  if (!split || (int)blockIdx.x >= nseq) {
    const int half = lane >> 5, v = (tid >> 6) * 32 + (lane & 31);
    const int first = split ? (int)blockIdx.x - nseq : (int)blockIdx.x, nb = split ? (int)gridDim.x - nseq : (int)gridDim.x;
    for (int item = first; item < 2048; item += nb) {
      const int b = item >> 4, h = item & 15;
      const int L = 8, tok0 = NP + b * 8, hq = h >> 1;
      float S[64];
      { const float* s0 = p.in[5] + ((size_t)(b * 16 + h) * 128 + half * 64) * 128 + v;
#pragma unroll
        for (int k = 0; k < 64; ++k) S[k] = s0[(size_t)k * 128]; }
      float nq = 0.f, nk = 0.f, nv, nbeta, ndec;
      const int pk = swap23(tid & 127);
      {
        const size_t tok = tok0;
        if (tid < 128) { nq = bf2f(QKV[tok * 4096 + hq * 128 + pk]); nk = bf2f(QKV[tok * 4096 + 1024 + hq * 128 + pk]); }
        nv = bf2f(QKV[tok * 4096 + 2048 + h * 128 + v]); nbeta = GATES[tok * 48 + h]; ndec = expf(GATES[tok * 48 + 16 + h]);
      }
      for (int t = 0; t < L; ++t) {
        float* qs = sm + (t & 1) * 256; float* ks = qs + 128;
        if (tid < 128) { qs[tid] = nq; ks[tid] = nk; }
        const float vv = nv, beta = nbeta, dec = ndec;
        __syncthreads();
        if (t + 1 < L) {
          const size_t tok = tok0 + t + 1;
          if (tid < 128) { nq = bf2f(QKV[tok * 4096 + hq * 128 + pk]); nk = bf2f(QKV[tok * 4096 + 1024 + hq * 128 + pk]); }
          nv = bf2f(QKV[tok * 4096 + 2048 + h * 128 + v]); nbeta = GATES[tok * 48 + h]; ndec = expf(GATES[tok * 48 + 16 + h]);
        }
        const float* kh = ks + half * 64; const float* qh = qs + half * 64;
        float dot = 0.f;
#pragma unroll
        for (int c = 0; c < 4; ++c) {
#pragma unroll
          for (int k = c * 16; k < c * 16 + 16; ++k) dot += kh[k] * S[k];
          __builtin_amdgcn_sched_barrier(0);
        }
        dot += __shfl_xor(dot, 32);
        const float vnew = beta * (vv - dec * dot);
        float o = 0.f;
#pragma unroll
        for (int c = 0; c < 4; ++c) {
#pragma unroll
          for (int k = c * 16; k < c * 16 + 16; ++k) { S[k] = dec * S[k] + kh[k] * vnew; o += qh[k] * S[k]; }
          __builtin_amdgcn_sched_barrier(0);
        }
        o += __shfl_xor(o, 32);
        if (half == 0) O[(size_t)(tok0 + t) * 2048 + h * 128 + v] = f2bf(o);
      }
      float* so = p.out + O_GDNS + ((size_t)(b * 16 + h) * 128 + half * 64) * 128 + v;
#pragma unroll
      for (int k = 0; k < 64; ++k) so[(size_t)k * 128] = S[k];
      __syncthreads();
    }
  }
}

DI void gdn_headnorm_body(const bf16_t* __restrict__ O, const bf16_t* __restrict__ Z, bf16_t* __restrict__ OG, const float* __restrict__ gain) {
  const int lane = otid() & 63, wid = otid() >> 6, sub = lane >> 4, l16 = lane & 15;
  float gn[8];
#pragma unroll
  for (int q = 0; q < 8; ++q) gn[q] = gain[l16 * 8 + q];
  for (int it0 = (blockIdx.x * 4 + wid) * 2; it0 < MT * 4; it0 += gridDim.x * 8) {
    uint4 ov[2], zv[2];
#pragma unroll
    for (int u = 0; u < 2; ++u) { const size_t off = (size_t)((it0 + u) >> 2) * 2048 + (((it0 + u) & 3) * 4 + sub) * 128 + l16 * 8;
      ov[u] = *(const uint4*)(O + off); zv[u] = *(const uint4*)(Z + off); }
#pragma unroll
    for (int u = 0; u < 2; ++u) { const size_t off = (size_t)((it0 + u) >> 2) * 2048 + (((it0 + u) & 3) * 4 + sub) * 128 + l16 * 8;
      const unsigned ow[4] = {ov[u].x, ov[u].y, ov[u].z, ov[u].w}, zw[4] = {zv[u].x, zv[u].y, zv[u].z, zv[u].w};
      float o[8], z[8]; float ss = 0.f;
#pragma unroll
      for (int q = 0; q < 4; ++q) { o[2 * q] = __uint_as_float(ow[q] << 16); o[2 * q + 1] = __uint_as_float(ow[q] & 0xffff0000u);
                                    z[2 * q] = __uint_as_float(zw[q] << 16); z[2 * q + 1] = __uint_as_float(zw[q] & 0xffff0000u); }
#pragma unroll
      for (int q = 0; q < 8; ++q) ss += o[q] * o[q];
      ss += __shfl_xor(ss, 1); ss += __shfl_xor(ss, 2); ss += __shfl_xor(ss, 4); ss += __shfl_xor(ss, 8);
      const float rstd = rsqrtf(ss * (1.0f / 128.0f) + 1e-6f);
      float y[8];
#pragma unroll
      for (int q = 0; q < 8; ++q) y[q] = o[q] * rstd * gn[q] * z[q] * sigmoidf_(z[q]);
      uint4 w; w.x = pack2(y[0], y[1]); w.y = pack2(y[2], y[3]); w.z = pack2(y[4], y[5]); w.w = pack2(y[6], y[7]);
      *(uint4*)(OG + off) = w; }
  }
}
DI void gdn_headnorm(const Params& p) {
  gdn_headnorm_body((const bf16_t*)(p.ws + W_SB + SC_GDN_OM), (const bf16_t*)(p.ws + W_SB + SC_GDN_Z), (bf16_t*)(p.ws + W_SB + SC_GDN_QKV), p.in[30]);
}


#define XB_TMO      128
#define XB_XCNT(j)  (256  + 64 * (j))
#define XB_XSUB(j)  (1280 + 64 * (j))
#define XB_XGEN(j)  (2304 + 64 * (j))
#define XB_TOP      3328
#define XB_TOPGEN   3392
#define XCD_BAR_WORDS 3456
#define XB_SPIN_CAP (1u << 20)
#define LAS __attribute__((address_space(3)))
DI unsigned xb_ld(unsigned* p)              { return __hip_atomic_load(p, __ATOMIC_RELAXED, __HIP_MEMORY_SCOPE_AGENT); }
DI unsigned xb_add(unsigned* p, unsigned v) { return __hip_atomic_fetch_add(p, v, __ATOMIC_RELAXED, __HIP_MEMORY_SCOPE_AGENT); }
DI unsigned xb_xcc_id() { return (unsigned)__builtin_amdgcn_s_getreg((3 << 11) | 20) & 0xFu; }
#define XB_SPIN(cond, bar) do { unsigned _sp = 0; while (cond) { __builtin_amdgcn_s_sleep(1); \
    if ((++_sp & 255u) == 0u) { if (xb_ld(&(bar)[XB_TMO])) break; if (_sp > XB_SPIN_CAP) { atomicAdd(&(bar)[XB_TMO], 1u); break; } } } } while (0)
struct XcdBarrier { unsigned* bar; unsigned x; volatile LAS unsigned* st; };
DI XcdBarrier xcd_barrier_post(unsigned* bar, volatile LAS unsigned* st) {
  XcdBarrier b; b.bar = bar; b.x = xb_xcc_id(); b.st = st;
  if (threadIdx.x == 0) (void)xb_add(&bar[XB_XCNT(b.x)], 1u);
  return b;
}
DI void xcd_barrier_complete(unsigned* bar, unsigned x, unsigned& nloc, unsigned& nx) {
  const unsigned G = gridDim.x * gridDim.y * gridDim.z;
  unsigned sum, cnt, mine, sp = 0u;
  for (;;) {
    sum = 0u; cnt = 0u; mine = 0u;
#pragma unroll
    for (unsigned j = 0; j < 16; ++j) { const unsigned c = xb_ld(&bar[XB_XCNT(j)]); sum += c; cnt += (c > 0u) ? 1u : 0u; mine = (j == x) ? c : mine; }
    if (sum == G) break;
    __builtin_amdgcn_s_sleep(1);
    if ((++sp & 255u) == 0u) { if (xb_ld(&bar[XB_TMO])) break; if (sp > XB_SPIN_CAP) { atomicAdd(&bar[XB_TMO], 1u); break; } }
  }
  nloc = mine > 0u ? mine : 1u; nx = cnt > 0u ? cnt : 1u;
}
DI void xcd_barrier(const XcdBarrier& b) {
  asm volatile("s_waitcnt vmcnt(0)" ::: "memory");
  __syncthreads();
  if (threadIdx.x == 0) {
    unsigned* bar = b.bar;
    __builtin_amdgcn_s_waitcnt(0);
    unsigned nloc = b.st[0], nx = b.st[1];
    if (nloc == 0u) { xcd_barrier_complete(bar, b.x, nloc, nx); b.st[0] = nloc; b.st[1] = nx; }
    const unsigned old = xb_add(&bar[XB_XSUB(b.x)], 1u);
    const unsigned gen = old / nloc;
    if (old + 1u == (gen + 1u) * nloc) {
      __builtin_amdgcn_fence(__ATOMIC_RELEASE, "agent");
      asm volatile("s_waitcnt vmcnt(0)" ::: "memory");
      const unsigned og = xb_add(&bar[XB_TOP], 1u);
      const unsigned tg = og / nx;
      if (og + 1u == (tg + 1u) * nx) xb_add(&bar[XB_TOPGEN], 1u);
      else XB_SPIN(xb_ld(&bar[XB_TOPGEN]) == tg, bar);
      __builtin_amdgcn_fence(__ATOMIC_ACQUIRE, "agent");
      xb_add(&bar[XB_XGEN(b.x)], 1u);
      asm volatile("s_waitcnt vmcnt(0)" ::: "memory");
    } else {
      XB_SPIN(xb_ld(&bar[XB_XGEN(b.x)]) == gen, bar);
      __builtin_amdgcn_fence(__ATOMIC_ACQUIRE, "agent");
      asm volatile("s_waitcnt vmcnt(0)" ::: "memory");
    }
  }
  __syncthreads();
}
template <int layer>
DI void layer_body(const Params& p, const XcdBarrier& xb, bf16_t* smem, float* smf) {
  char* ws = p.ws;
  float* H = (float*)(ws + W_H);
  bf16_t* wt_up = (bf16_t*)(ws + W_UP); bf16_t* wt_down = (bf16_t*)(ws + W_DOWN);
  bf16_t* wt_in = (bf16_t*)(ws + W_MIXIN); bf16_t* wt_out = (bf16_t*)(ws + W_MIXOUT);
  bf16_t* HN = (bf16_t*)(ws + W_SB + SC_HN); bf16_t* ACT = (bf16_t*)(ws + W_SB + SC_ACT);
    const int kind = layer % 3, j = layer / 3;
    REPM1 convert_w<0>(p.in[10] + (size_t)layer * 1024 * 4096, 1024, 4096, wt_up, 4096, smf);
    REPM1 convert_w<0>(p.in[11] + (size_t)layer * 4096 * 1024, 4096, 1024, wt_down, 1024, smf);
    if (kind == 0) {
      REPM1 convert_w<1>(p.in[20] + (size_t)j * 1024 * 2048, 1024, 2048, wt_in, 2048, smf);
      REPM1 norm_phase<1>(p, p.in[7] + layer * 1024, layer == 0, (bf16_t*)(ws + W_SB + SC_UP));
    } else if (kind == 1) {
      REPM1 convert_w<0>(p.in[21], 1024, 3088, wt_in, 3200, smf);
      REPM1 convert_w<0>(p.in[25], 1024, 1024, wt_out, 1024, smf);
      REPM1 norm_phase<0>(p, p.in[7] + layer * 1024, false, HN);
    } else {
      REPM1 convert_w<0>(p.in[26], 1024, 6176, wt_in, 6272, smf);
      REPM1 convert_w<0>(p.in[31], 2048, 1024, wt_out, 1024, smf);
      REPM1 norm_phase<0>(p, p.in[7] + layer * 1024, false, (bf16_t*)(ws + W_SB + SC_GDN_QKV));
    }
    GSYNC();
    if (kind == 0) {
      const char* matb = ws + W_S5MAT + (size_t)j * S5MAT_STRIDE;
      const bf16_t* wcat = (const bf16_t*)(matb + S5_WCAT); const bf16_t* wst = (const bf16_t*)(matb + S5_WST);
      bf16_t* up = (bf16_t*)(ws + W_SB + SC_UP); float* sloc = (float*)(ws + W_SB + SC_SLOC); bf16_t* gbuf = (bf16_t*)(ws + W_SB + SC_GBUF);
      REPG for (int t = blockIdx.x; t < 17 * 64; t += gridDim.x) {
        const int g = t / 17, mt = t % 17;
        EpiS5Loc e{sloc, mt * 128, g};
        gemm_tile(up + ((size_t)g * NR + mt * 128) * 256, 256, wst + (size_t)g * 128 * 128, 128, 128, e, smem);
      }
      GSYNC();
      REPM2 s5_carry(p, j);
      GSYNC();
      REPG for (int t = blockIdx.x; t < 17 * 64; t += gridDim.x) {
        const int g = t / 17, mt = t % 17;
        EpiS5Out e{up, p.in[19] + j * 1024, gbuf, mt * 128, g};
        gemm_tile(up + ((size_t)g * NR + mt * 128) * 256, 256, wcat + (size_t)g * 128 * 256, 256, 256, e, smem);
      }
      GSYNC();
      for (int t = blockIdx.x; t < 136 * 16; t += gridDim.x) {
        const int mt = t / 16, nt = t % 16;
        EpiGLU e{H, mt * 128, nt * 128};
        gemm_tile(gbuf + (size_t)mt * 128 * 1024, 1024, wt_in + (size_t)nt * 128 * 1024, 1024, 1024, e, smem);
      }
      GSYNC();
    } else if (kind == 1) {
      bf16_t* P = (bf16_t*)(ws + W_SB + SC_GLA_P); float* GL = (float*)(ws + W_SB + SC_GLA_GL);
      REPG for (int t = blockIdx.x; t < 136 * 25; t += gridDim.x) {
        const int nt = t / 136, mt = t % 136;
        EpiGlaIn e{P, GL, mt * 128, nt * 128};
        gemm_tile(HN + (size_t)mt * 128 * 1024, 1024, wt_in + (size_t)nt * 128 * 1024, 1024, 1024, e, smem);
      }
      GSYNC();
      REPM3 gla_prep(p, smf);
      GSYNC();
      REPG gla_aqk(p, smem);
      GSYNC();
      for (int rep = 0; rep < DUP_REC; ++rep) gla_rec(p, smf);
      GSYNC();
      REPM3 gla_headnorm(p);
      GSYNC();
      for (int t = blockIdx.x; t < 136 * 8; t += gridDim.x) {
        const int mt = t / 8, nt = t % 8;
        EpiResid e{H, mt * 128, nt * 128};
        gemm_tile(HN + (size_t)mt * 128 * 1024, 1024, wt_out + (size_t)nt * 128 * 1024, 1024, 1024, e, smem);
      }
      GSYNC();
    } else {
      bf16_t* hn2 = (bf16_t*)(ws + W_SB + SC_GDN_QKV);
      REPG for (int t = blockIdx.x; t < 136 * 49; t += gridDim.x) {
        const int nt = t / 136, mt = t % 136;
        EpiGdnIn e{(bf16_t*)(ws + W_SB + SC_GDN_PRE), (bf16_t*)(ws + W_SB + SC_GDN_Z), (float*)(ws + W_SB + SC_GDN_BA), p.out + O_CONVP, p.out + O_CONVS, mt * 128, nt * 128};
        gemm_tile(hn2 + (size_t)mt * 128 * 1024, 1024, wt_in + (size_t)nt * 128 * 1024, 1024, 1024, e, smem);
      }
      GSYNC();
      REPM4 gdn_conv(p);
      GSYNC();
      REPG gdn_kkqk(p, smem);
      GSYNC();
      REPM4 gdn_inverse(p, smf);
      GSYNC();
      for (int rep = 0; rep < DUP_REC; ++rep) gdn_rec(p, smf);
      GSYNC();
      REPM4 gdn_headnorm(p);
      GSYNC();
      for (int t = blockIdx.x; t < 136 * 8; t += gridDim.x) {
        const int mt = t / 8, nt = t % 8;
        EpiResid e{H, mt * 128, nt * 128};
        gemm_tile(hn2 + (size_t)mt * 128 * 2048, 2048, wt_out + (size_t)nt * 128 * 2048, 2048, 2048, e, smem);
      }
      GSYNC();
    }
    REPM1 norm_phase<0>(p, p.in[8] + layer * 1024, false, HN);
    GSYNC();
    for (int rep = 0; rep < DUP_UP; ++rep)
    for (int t = blockIdx.x; t < 136 * 32; t += gridDim.x) {
      const int nt = t / 136, mt = t % 136;
      EpiRelu2 e{ACT, mt * 128, nt * 128};
      gemm_tile(HN + (size_t)mt * 128 * 1024, 1024, wt_up + (size_t)nt * 128 * 1024, 1024, 1024, e, smem);
    }
    GSYNC();
    for (int t = blockIdx.x; t < 136 * 8; t += gridDim.x) {
      const int mt = t / 8, nt = t % 8;
      EpiResid e{H, mt * 128, nt * 128};
      gemm_tile(ACT + (size_t)mt * 128 * 4096, 4096, wt_down + (size_t)nt * 128 * 4096, 4096, 4096, e, smem);
    }
    GSYNC();
  }

__global__ void __launch_bounds__(256, 2) fwd_megakernel(Params p) {
  __shared__ __attribute__((aligned(16))) char smem_raw[73728];
  __shared__ uint4 xb_words;
  cg::grid_group grid = cg::this_grid();
  unsigned* barw = (unsigned*)(p.ws + W_BAR);
  if (threadIdx.x == 0) xb_words = make_uint4(0u, 0u, 0u, 0u);
  __syncthreads();
  if (p.ws == nullptr) grid.sync();
  XcdBarrier xb = xcd_barrier_post(barw, (volatile LAS unsigned*)&xb_words);
  bf16_t* smem = (bf16_t*)smem_raw;
  float* smf = (float*)smem_raw;
  char* ws = p.ws;
  float* H = (float*)(ws + W_H);
  bf16_t* wt_up = (bf16_t*)(ws + W_UP); bf16_t* wt_down = (bf16_t*)(ws + W_DOWN);
  bf16_t* wt_in = (bf16_t*)(ws + W_MIXIN); bf16_t* wt_out = (bf16_t*)(ws + W_MIXOUT);
  bf16_t* HN = (bf16_t*)(ws + W_SB + SC_HN); bf16_t* ACT = (bf16_t*)(ws + W_SB + SC_ACT);

  REPM2 s5_mats(p, smf);

  layer_body<0>(p, xb, smem, smf);
  layer_body<1>(p, xb, smem, smf);
  layer_body<2>(p, xb, smem, smf);
  layer_body<3>(p, xb, smem, smf);
  REPM1 norm_phase<2>(p, p.in[9], false, nullptr);
}

extern "C" void kernel_launch(void* const* d_in, const int* in_sizes, int n_in, void* d_out, int out_size,
                              void* d_ws, size_t ws_size, hipStream_t stream) {
  static int grid_blocks = 0;
  if (!grid_blocks) {
    int dev = 0, cus = 0, per_cu = 0;
    hipGetDevice(&dev);
    hipDeviceGetAttribute(&cus, hipDeviceAttributeMultiprocessorCount, dev);
    hipOccupancyMaxActiveBlocksPerMultiprocessor(&per_cu, fwd_megakernel, 256, 0);
    if (per_cu > 2) per_cu = 2;
    if (per_cu < 1) per_cu = 1;
    grid_blocks = cus * per_cu;
  }
  if (ws_size < WS_NEED) fprintf(stderr, "workspace too small: %zu < %zu\n", ws_size, (size_t)WS_NEED);
  Params p{};
  for (int i = 0; i < 32; ++i) p.in[i] = (const float*)d_in[i];
  p.out = (float*)d_out; p.ws = (char*)d_ws;
  hipMemsetAsync((char*)d_ws + W_BAR, 0, XCD_BAR_WORDS * sizeof(unsigned), stream);
  void* args[] = {&p};
  hipError_t e = hipLaunchCooperativeKernel((void*)fwd_megakernel, dim3(grid_blocks), dim3(256), args, 0, stream);
  if (e != hipSuccess) fprintf(stderr, "cooperative launch failed: %s (grid %d)\n", hipGetErrorString(e), grid_blocks);
}
```

```cpp
#include <hip/hip_runtime.h>
#include <hip/hip_cooperative_groups.h>
#include <cstdio>
#include <cstdint>
namespace cg = cooperative_groups;

typedef unsigned short bf16_t;
typedef short bf16x8 __attribute__((ext_vector_type(8)));
typedef float f32x16 __attribute__((ext_vector_type(16)));
#define DI __device__ __forceinline__
#ifndef DUP_UP
#define DUP_UP 1
#endif
#ifndef DUP_REC
#define DUP_REC 1
#endif
#ifndef DUP_SYNC
#define DUP_SYNC 1
#endif
#ifndef DUP_MISC
#define DUP_MISC 1
#endif
#ifndef DUP_G2
#define DUP_G2 1
#endif
#define GSYNC() do { for (int rs_ = 0; rs_ < DUP_SYNC; ++rs_) xcd_barrier(xb); } while (0)
#define REPM for (int rm_ = 0; rm_ < DUP_MISC; ++rm_)
#ifndef DUP_M1
#define DUP_M1 1
#endif
#ifndef DUP_M2
#define DUP_M2 1
#endif
#ifndef DUP_M3
#define DUP_M3 1
#endif
#ifndef DUP_M4
#define DUP_M4 1
#endif
#define REPM1 for (int rm1_ = 0; rm1_ < DUP_M1; ++rm1_)
#define REPM2 for (int rm2_ = 0; rm2_ < DUP_M2; ++rm2_)
#define REPM3 for (int rm3_ = 0; rm3_ < DUP_M3; ++rm3_)
#define REPM4 for (int rm4_ = 0; rm4_ < DUP_M4; ++rm4_)
#define REPG for (int rg_ = 0; rg_ < DUP_G2; ++rg_)

constexpr int NP = 16384;
constexpr int MT = 17408;
constexpr int NR = 2176;
constexpr size_t O_YP = 0, O_YS = 16777216, O_S5RP = 17825792, O_S5IP = 17891328, O_GLAP = 17956864, O_GDNP = 19005440,
                 O_CONVP = 21102592, O_S5RS = 21200896, O_S5IS = 22249472, O_GLAS = 23298048, O_GDNS = 40075264, O_CONVS = 73629696;
constexpr size_t W_UP = 0, W_DOWN = 8388608, W_MIXIN = 16777216, W_MIXOUT = 30408704, W_S5MAT = 34603008, W_H = 50331648, W_SB = 127926272;
constexpr size_t W_BAR = 47251456;
constexpr size_t S5MAT_STRIDE = 6324224, S5_WCAT = 0, S5_WST = 4194304, S5_AP8 = 6291456;
constexpr size_t WS_NEED = W_SB + 395640832;
constexpr size_t SC_HN = 0, SC_ACT = 37748736;
constexpr size_t SC_UP = 0, SC_SLOC = 75497472, SC_GBUF = 154140672;
constexpr size_t SC_GLA_P = 37748736, SC_GLA_GL = 152043520, SC_GLA_GATE = 154140672, SC_GLA_O = 190840832;
constexpr size_t SC_GLA_QT = 262144000, SC_GLA_KTL = 278921216, SC_GLA_KDT = 295698432, SC_GLA_DL = 312475648, SC_GLA_AQK = 312999936;
constexpr size_t SC_GDN_PRE = 0, SC_GDN_Z = 142606336, SC_GDN_BA = 213909504, SC_GDN_QKV = 216137728;
constexpr size_t SC_GDN_OM = 0, SC_GDN_AQK = 71303168, SC_GDN_TINV = 104857600, SC_GDN_KT = 358744064, SC_GDN_GATES = 392298496;

struct Params { const float* in[32]; float* out; char* ws; };

typedef __bf16 hbf16x2_t __attribute__((ext_vector_type(2)));
typedef float hf32x2_t __attribute__((ext_vector_type(2)));
typedef unsigned u32x4_t __attribute__((ext_vector_type(4)));
DI unsigned pack2(float a, float b) { hf32x2_t v = {a, b}; return __builtin_bit_cast(unsigned, __builtin_convertvector(v, hbf16x2_t)); }
DI bf16_t f2bf(float x) { return (bf16_t)(pack2(x, 0.f) & 0xffffu); }
DI float bf2f(bf16_t b) { return __uint_as_float(((unsigned)b) << 16); }

DI float sigmoidf_(float x) { return 1.0f / (1.0f + __expf(-x)); }
DI float softplusf_(float x) { return fmaxf(x, 0.f) + log1pf(__expf(-fabsf(x))); }
DI int otid() { int t = __builtin_amdgcn_workitem_id_x(); asm volatile("" : "+v"(t)); return t; }
DI int swap23(int k) { return (k & ~12) | ((k & 4) << 1) | ((k & 8) >> 1); }
DI int crow(int reg, int hh) { return (reg & 3) + 8 * (reg >> 2) + 4 * hh; }
template <int SS> DI bf16x8 pack8(const f32x16& x) {
  u32x4_t r; r.x = pack2(x[8 * SS], x[8 * SS + 1]); r.y = pack2(x[8 * SS + 2], x[8 * SS + 3]); r.z = pack2(x[8 * SS + 4], x[8 * SS + 5]); r.w = pack2(x[8 * SS + 6], x[8 * SS + 7]);
  return __builtin_bit_cast(bf16x8, r); }
DI float wave_sum(float v) {
#pragma unroll
  for (int o = 32; o > 0; o >>= 1) v += __shfl_xor(v, o);
  return v;
}

constexpr int LSTR = 72;
constexpr int TILE_E = 128 * LSTR;

template <class Epi>
DI void gemm_tile(const bf16_t* __restrict__ A, int lda, const bf16_t* __restrict__ Bt, int ldb, int K, const Epi& epi, bf16_t* smem) {
  const int tid = otid(), lane = tid & 63, wid = tid >> 6, wr = wid >> 1, wc = wid & 1;
  const int lr = tid >> 3, lc = (tid & 7) * 8;
  f32x16 acc[2][2];
#pragma unroll
  for (int i = 0; i < 2; ++i)
#pragma unroll
    for (int j = 0; j < 2; ++j)
#pragma unroll
      for (int r = 0; r < 16; ++r) acc[i][j][r] = 0.f;
  uint4 a00, b00, a01, b01, a02, b02, a03, b03, a10, b10, a11, b11, a12, b12, a13, b13;
  const bf16_t* Ap = A + (size_t)lr * lda + lc;
  const bf16_t* Bp = Bt + (size_t)lr * ldb + lc;
  const int nk = K >> 6;
      a00 = *(const uint4*)(Ap + (size_t)(0) * lda + 0); b00 = *(const uint4*)(Bp + (size_t)(0) * ldb + 0);
      a01 = *(const uint4*)(Ap + (size_t)(32) * lda + 0); b01 = *(const uint4*)(Bp + (size_t)(32) * ldb + 0);
      a02 = *(const uint4*)(Ap + (size_t)(64) * lda + 0); b02 = *(const uint4*)(Bp + (size_t)(64) * ldb + 0);
      a03 = *(const uint4*)(Ap + (size_t)(96) * lda + 0); b03 = *(const uint4*)(Bp + (size_t)(96) * ldb + 0);
      a10 = *(const uint4*)(Ap + (size_t)(0) * lda + 64); b10 = *(const uint4*)(Bp + (size_t)(0) * ldb + 64);
      a11 = *(const uint4*)(Ap + (size_t)(32) * lda + 64); b11 = *(const uint4*)(Bp + (size_t)(32) * ldb + 64);
      a12 = *(const uint4*)(Ap + (size_t)(64) * lda + 64); b12 = *(const uint4*)(Bp + (size_t)(64) * ldb + 64);
      a13 = *(const uint4*)(Ap + (size_t)(96) * lda + 64); b13 = *(const uint4*)(Bp + (size_t)(96) * ldb + 64);
      { bf16_t* da = smem + 0 * 2 * TILE_E; bf16_t* db = da + TILE_E;
        *(uint4*)(da + (lr + 0) * LSTR + lc) = a00; *(uint4*)(db + (lr + 0) * LSTR + lc) = b00;
        *(uint4*)(da + (lr + 32) * LSTR + lc) = a01; *(uint4*)(db + (lr + 32) * LSTR + lc) = b01;
        *(uint4*)(da + (lr + 64) * LSTR + lc) = a02; *(uint4*)(db + (lr + 64) * LSTR + lc) = b02;
        *(uint4*)(da + (lr + 96) * LSTR + lc) = a03; *(uint4*)(db + (lr + 96) * LSTR + lc) = b03;
      }
  __syncthreads();
  for (int kt = 0; kt < nk; kt += 2) {
    {
      const int kn = min(kt + 2, nk - 1) << 6;
      a00 = *(const uint4*)(Ap + (size_t)(0) * lda + kn); b00 = *(const uint4*)(Bp + (size_t)(0) * ldb + kn);
      a01 = *(const uint4*)(Ap + (size_t)(32) * lda + kn); b01 = *(const uint4*)(Bp + (size_t)(32) * ldb + kn);
      a02 = *(const uint4*)(Ap + (size_t)(64) * lda + kn); b02 = *(const uint4*)(Bp + (size_t)(64) * ldb + kn);
      a03 = *(const uint4*)(Ap + (size_t)(96) * lda + kn); b03 = *(const uint4*)(Bp + (size_t)(96) * ldb + kn);
      { const bf16_t* sa = smem + 0 * 2 * TILE_E; const bf16_t* sb = sa + TILE_E;
#pragma unroll
      for (int kk = 0; kk < 4; ++kk) {
        bf16x8 af[2], bfr[2];
#pragma unroll
        for (int i = 0; i < 2; ++i) af[i] = *(const bf16x8*)(sa + (wr * 64 + i * 32 + (lane & 31)) * LSTR + kk * 16 + (lane >> 5) * 8);
#pragma unroll
        for (int j = 0; j < 2; ++j) bfr[j] = *(const bf16x8*)(sb + (wc * 64 + j * 32 + (lane & 31)) * LSTR + kk * 16 + (lane >> 5) * 8);
#pragma unroll
        for (int i = 0; i < 2; ++i)
#pragma unroll
          for (int j = 0; j < 2; ++j) acc[i][j] = __builtin_amdgcn_mfma_f32_32x32x16_bf16(af[i], bfr[j], acc[i][j], 0, 0, 0);
      } }
      { bf16_t* da = smem + 1 * 2 * TILE_E; bf16_t* db = da + TILE_E;
        *(uint4*)(da + (lr + 0) * LSTR + lc) = a10; *(uint4*)(db + (lr + 0) * LSTR + lc) = b10;
        *(uint4*)(da + (lr + 32) * LSTR + lc) = a11; *(uint4*)(db + (lr + 32) * LSTR + lc) = b11;
        *(uint4*)(da + (lr + 64) * LSTR + lc) = a12; *(uint4*)(db + (lr + 64) * LSTR + lc) = b12;
        *(uint4*)(da + (lr + 96) * LSTR + lc) = a13; *(uint4*)(db + (lr + 96) * LSTR + lc) = b13;
      }
      __syncthreads();
    }
    {
      const int kn = min(kt + 3, nk - 1) << 6;
      a10 = *(const uint4*)(Ap + (size_t)(0) * lda + kn); b10 = *(const uint4*)(Bp + (size_t)(0) * ldb + kn);
      a11 = *(const uint4*)(Ap + (size_t)(32) * lda + kn); b11 = *(const uint4*)(Bp + (size_t)(32) * ldb + kn);
      a12 = *(const uint4*)(Ap + (size_t)(64) * lda + kn); b12 = *(const uint4*)(Bp + (size_t)(64) * ldb + kn);
      a13 = *(const uint4*)(Ap + (size_t)(96) * lda + kn); b13 = *(const uint4*)(Bp + (size_t)(96) * ldb + kn);
      { const bf16_t* sa = smem + 1 * 2 * TILE_E; const bf16_t* sb = sa + TILE_E;
#pragma unroll
      for (int kk = 0; kk < 4; ++kk) {
        bf16x8 af[2], bfr[2];
#pragma unroll
        for (int i = 0; i < 2; ++i) af[i] = *(const bf16x8*)(sa + (wr * 64 + i * 32 + (lane & 31)) * LSTR + kk * 16 + (lane >> 5) * 8);
#pragma unroll
        for (int j = 0; j < 2; ++j) bfr[j] = *(const bf16x8*)(sb + (wc * 64 + j * 32 + (lane & 31)) * LSTR + kk * 16 + (lane >> 5) * 8);
#pragma unroll
        for (int i = 0; i < 2; ++i)
#pragma unroll
          for (int j = 0; j < 2; ++j) acc[i][j] = __builtin_amdgcn_mfma_f32_32x32x16_bf16(af[i], bfr[j], acc[i][j], 0, 0, 0);
      } }
      { bf16_t* da = smem + 0 * 2 * TILE_E; bf16_t* db = da + TILE_E;
        *(uint4*)(da + (lr + 0) * LSTR + lc) = a00; *(uint4*)(db + (lr + 0) * LSTR + lc) = b00;
        *(uint4*)(da + (lr + 32) * LSTR + lc) = a01; *(uint4*)(db + (lr + 32) * LSTR + lc) = b01;
        *(uint4*)(da + (lr + 64) * LSTR + lc) = a02; *(uint4*)(db + (lr + 64) * LSTR + lc) = b02;
        *(uint4*)(da + (lr + 96) * LSTR + lc) = a03; *(uint4*)(db + (lr + 96) * LSTR + lc) = b03;
      }
      __syncthreads();
    }
  }
#pragma unroll
  for (int i = 0; i < 2; ++i)
#pragma unroll
    for (int r = 0; r < 16; ++r) {
      const int row = wr * 64 + i * 32 + (r & 3) + 8 * (r >> 2) + 4 * (lane >> 5);
      epi(row, wc * 64 + (lane & 31), acc[i][0][r], acc[i][1][r]);
    }
}

struct EpiRelu2 { bf16_t* act; int m0, n0;
  DI void operator()(int row, int col, float v0, float v1) const {
    bf16_t* d = act + (size_t)(m0 + row) * 4096 + n0 + col; float a = fmaxf(v0, 0.f), b = fmaxf(v1, 0.f); d[0] = f2bf(a * a); d[32] = f2bf(b * b); } };
struct EpiResid { float* h; int m0, n0;
  DI void operator()(int row, int col, float v0, float v1) const { float* d = h + (size_t)(m0 + row) * 1024 + n0 + col; d[0] += v0; d[32] += v1; } };
struct EpiGLU { float* h; int m0, n0;
  DI void operator()(int row, int col, float v0, float v1) const { const int n = n0 + col; float* d = h + (size_t)(m0 + row) * 1024 + (n >> 6) * 32 + (n & 31); d[0] += v0 * sigmoidf_(v1); } };
struct EpiGlaIn { bf16_t* P; float* GL; int m0, n0;
  DI void one(int row, int n, float v) const { if (n < 3072) P[(size_t)(m0 + row) * 3072 + n] = f2bf(v); else if (n < 3088) GL[(size_t)(m0 + row) * 16 + (n - 3072)] = v; }
  DI void operator()(int row, int col, float v0, float v1) const { one(row, n0 + col, v0); one(row, n0 + col + 32, v1); } };
struct EpiGdnIn { bf16_t* PRE; bf16_t* Z; float* BA; float* convp; float* convs; int m0, n0;
  DI void one(int tok, int n, float v) const {
    if (n < 4096) {
      PRE[(size_t)tok * 4096 + n] = f2bf(v);
      if (tok < NP) { const int l = tok & 2047; if (l >= 2045) convp[((size_t)(tok >> 11) * 3 + (l - 2045)) * 4096 + n] = v; }
      else { const int ts = tok - NP, l = ts & 7; if (l >= 5) convs[((size_t)(ts >> 3) * 3 + (l - 5)) * 4096 + n] = v; }
    } else if (n < 6144) Z[(size_t)tok * 2048 + (n - 4096)] = f2bf(v);
    else if (n < 6176) BA[(size_t)tok * 32 + (n - 6144)] = v;
  }
  DI void operator()(int row, int col, float v0, float v1) const { one(m0 + row, n0 + col, v0); one(m0 + row, n0 + col + 32, v1); } };
struct EpiS5Loc { float* sloc; int m0, g;
  DI void operator()(int row, int col, float v0, float v1) const { float* d = sloc + ((size_t)(m0 + row) * 64 + g) * 128 + col; d[0] = v0; d[32] = v1; } };
DI float gelu_tanh(float y) { return 0.5f * y * (1.0f + tanhf(0.7978845608028654f * (y + 0.044715f * y * y * y))); }
struct EpiS5Out { const bf16_t* up; const float* dsk; bf16_t* gbuf; int m0, g;
  DI void one(int r, int n, float v) const {
    const int t = n >> 4, c = n & 15, ch = g * 16 + c;
    const float hn = bf2f(up[((size_t)g * NR + r) * 256 + n]);
    gbuf[(size_t)(r * 8 + t) * 1024 + ch] = f2bf(gelu_tanh(v + dsk[ch] * hn));
  }
  DI void operator()(int row, int col, float v0, float v1) const { one(m0 + row, col, v0); one(m0 + row, col + 32, v1); } };

template <int MODE>
DI void convert_w(const float* __restrict__ W, int K, int N, bf16_t* __restrict__ Wt, int Npad, float* tilef) {
  bf16_t* tileS = (bf16_t*)tilef;
  const int nkt = K >> 6, nnt = (Npad + 511) >> 9, nt = nkt * nnt;
  const int tid = otid(), lane = tid & 63, wid = tid >> 6;
  for (int t = blockIdx.x; t < nt; t += gridDim.x) {
    const int kt = t % nkt, ntile = t / nkt, k0 = kt << 6, n0 = ntile << 9;
    int srcc[2]; float msk[2];
#pragma unroll
    for (int q = 0; q < 2; ++q) {
      const int nd = n0 + 4 * (lane + 64 * q);
      const int src = (MODE == 1) ? (((nd >> 5) & 1) * 1024 + (nd >> 6) * 32 + (nd & 31)) : nd;
      const bool ok = nd < N;
      srcc[q] = ok ? src : 0; msk[q] = ok ? 1.0f : 0.0f;
    }
#pragma unroll
    for (int hb = 0; hb < 2; ++hb) {
      float4 v[8][2];
#pragma unroll
      for (int r = 0; r < 8; ++r)
#pragma unroll
        for (int q = 0; q < 2; ++q) v[r][q] = *(const float4*)(W + (size_t)(k0 + wid * 16 + hb * 8 + r) * N + srcc[q]);
#pragma unroll
      for (int r = 0; r < 8; r += 2)
#pragma unroll
        for (int q = 0; q < 2; ++q) {
          const int row = wid * 16 + hb * 8 + r, nl = 4 * (lane + 64 * q);
          const float m = msk[q];
          *(unsigned*)(tileS + (nl + 0) * 68 + row) = pack2(v[r][q].x * m, v[r + 1][q].x * m);
          *(unsigned*)(tileS + (nl + 1) * 68 + row) = pack2(v[r][q].y * m, v[r + 1][q].y * m);
          *(unsigned*)(tileS + (nl + 2) * 68 + row) = pack2(v[r][q].z * m, v[r + 1][q].z * m);
          *(unsigned*)(tileS + (nl + 3) * 68 + row) = pack2(v[r][q].w * m, v[r + 1][q].w * m);
        }
    }
    __syncthreads();
#pragma unroll 4
    for (int u = 0; u < 16; ++u) {
      const int nl = (tid >> 3) + 32 * u, kc = (tid & 7) * 8;
      if (n0 + nl < Npad) {
        const uint2 a = *(const uint2*)(tileS + nl * 68 + kc), b = *(const uint2*)(tileS + nl * 68 + kc + 4);
        *(uint4*)(Wt + (size_t)(n0 + nl) * K + k0 + kc) = make_uint4(a.x, a.y, b.x, b.y);
      }
    }
    __syncthreads();
  }
}

DI void s5_mats(const Params& p, float* sm) {
  float* pw_re = sm; float* pw_im = sm + 576; float* cf_re = sm + 1152; float* cf_im = sm + 1216;
  float* bb_re = sm + 1280; float* bb_im = sm + 2304; float* cc_re = sm + 3328; float* cc_im = sm + 4352; float* kt = sm + 5376;
  const int tid = otid();
  for (int task = blockIdx.x; task < 128; task += gridDim.x) {
    const int j = task >> 6, g = task & 63, jg = j * 64 + g;
    char* matb = p.ws + W_S5MAT + (size_t)j * S5MAT_STRIDE;
    bf16_t* wcat = (bf16_t*)(matb + S5_WCAT) + (size_t)g * 128 * 256;
    bf16_t* wst = (bf16_t*)(matb + S5_WST) + (size_t)g * 128 * 128;
    float* ap8 = (float*)(matb + S5_AP8) + (size_t)g * 128;
    if (tid < 64) {
      const float dt = expf(p.in[14][jg]);
      const float are = p.in[12][jg * 64 + tid], aim = p.in[13][jg * 64 + tid];
      const float x = are * dt, y = aim * dt;
      for (int m = 0; m <= 8; ++m) { float s, c; sincosf(y * (float)m, &s, &c); const float mag = expf(x * (float)m); pw_re[m * 64 + tid] = mag * c; pw_im[m * 64 + tid] = mag * s; }
      float s, c; sincosf(y, &s, &c); const float sh = sinf(0.5f * y); const float em1 = expm1f(x);
      const float nr = em1 * c - 2.0f * sh * sh, ni = (em1 + 1.0f) * s;
      const float den = are * are + aim * aim;
      cf_re[tid] = (nr * are + ni * aim) / den; cf_im[tid] = (ni * are - nr * aim) / den;
      ap8[tid * 2] = pw_re[8 * 64 + tid]; ap8[tid * 2 + 1] = pw_im[8 * 64 + tid];
    }
    __syncthreads();
    for (int e = tid; e < 1024; e += 256) {
      const int pp = e >> 4;
      const float br = p.in[15][(size_t)jg * 1024 + e], bi = p.in[16][(size_t)jg * 1024 + e];
      bb_re[e] = cf_re[pp] * br - cf_im[pp] * bi; bb_im[e] = cf_re[pp] * bi + cf_im[pp] * br;
      cc_re[e] = p.in[17][(size_t)jg * 1024 + e]; cc_im[e] = p.in[18][(size_t)jg * 1024 + e];
    }
    __syncthreads();
    for (int e = tid; e < 2048; e += 256) {
      const int m = e >> 8, c = (e >> 4) & 15, ch = e & 15;
      float acc = 0.f;
      for (int pp = 0; pp < 64; ++pp) {
        const float cr = cc_re[c * 64 + pp], ci = cc_im[c * 64 + pp], wr_ = pw_re[m * 64 + pp], wi = pw_im[m * 64 + pp];
        const float tr = cr * wr_ - ci * wi, ti = cr * wi + ci * wr_;
        acc += tr * bb_re[pp * 16 + ch] - ti * bb_im[pp * 16 + ch];
      }
      kt[e] = acc;
    }
    __syncthreads();
    for (int e = tid; e < 16384; e += 256) {
      const int pq = e >> 7, k = e & 127, s = k >> 4, ch = k & 15, pp = pq & 63, m = 7 - s;
      const float wr_ = pw_re[m * 64 + pp], wi = pw_im[m * 64 + pp], br = bb_re[pp * 16 + ch], bi = bb_im[pp * 16 + ch];
      wst[e] = f2bf(pq < 64 ? (wr_ * br - wi * bi) : (wr_ * bi + wi * br));
    }
    for (int e = tid; e < 32768; e += 256) {
      const int n = e >> 8, k = e & 255, t = n >> 4, c = n & 15;
      float val;
      if (k < 128) { const int s = k >> 4, ch = k & 15; val = (s <= t) ? kt[(t - s) * 256 + c * 16 + ch] : 0.f; }
      else { const int pq = k - 128, pp = pq & 63; const float cr = cc_re[c * 64 + pp], ci = cc_im[c * 64 + pp], wr_ = pw_re[(t + 1) * 64 + pp], wi = pw_im[(t + 1) * 64 + pp];
             val = pq < 64 ? (cr * wr_ - ci * wi) : -(cr * wi + ci * wr_); }
      wcat[e] = f2bf(val);
    }
    __syncthreads();
  }
}

template <int MODE>
DI void norm_phase(const Params& p, const float* __restrict__ gain, bool first, bf16_t* __restrict__ dst) {
  float* __restrict__ H = (float*)(p.ws + W_H);
  const int lane = otid() & 63, wid = otid() >> 6;
  for (int row0 = (blockIdx.x * 4 + wid) * 2; row0 < MT; row0 += gridDim.x * 8) {
    float4 v[2][4]; float ss[2] = {0.f, 0.f};
#pragma unroll
    for (int u = 0; u < 2; ++u) {
      const int row = row0 + u;
      const float* src = first ? (row < NP ? p.in[0] + (size_t)row * 1024 : p.in[1] + (size_t)(row - NP) * 1024) : H + (size_t)row * 1024;
#pragma unroll
      for (int i = 0; i < 4; ++i) v[u][i] = ((const float4*)src)[lane + 64 * i];
    }
#pragma unroll
    for (int u = 0; u < 2; ++u) {
#pragma unroll
      for (int i = 0; i < 4; ++i) ss[u] += v[u][i].x * v[u][i].x + v[u][i].y * v[u][i].y + v[u][i].z * v[u][i].z + v[u][i].w * v[u][i].w;
      ss[u] = wave_sum(ss[u]);
    }
#pragma unroll
    for (int u = 0; u < 2; ++u) {
      const int row = row0 + u;
      const float rstd = rsqrtf(ss[u] * (1.0f / 1024.0f) + 1e-6f);
      if (first) {
#pragma unroll
        for (int i = 0; i < 4; ++i) ((float4*)(H + (size_t)row * 1024))[lane + 64 * i] = v[u][i];
      }
#pragma unroll
      for (int i = 0; i < 4; ++i) {
        const int c = (lane + 64 * i) * 4;
        const float4 g4 = *(const float4*)(gain + c);
        const float y0 = v[u][i].x * rstd * g4.x, y1 = v[u][i].y * rstd * g4.y, y2 = v[u][i].z * rstd * g4.z, y3 = v[u][i].w * rstd * g4.w;
        if (MODE == 0) { uint2 w; w.x = pack2(y0, y1); w.y = pack2(y2, y3); *(uint2*)(dst + (size_t)row * 1024 + c) = w; }
        else if (MODE == 1) { const int g = c >> 4, ch = c & 15, r = row >> 3, t = row & 7; uint2 w; w.x = pack2(y0, y1); w.y = pack2(y2, y3);
                              *(uint2*)(dst + ((size_t)g * NR + r) * 256 + t * 16 + ch) = w; }
        else { float* o = row < NP ? p.out + O_YP + (size_t)row * 1024 + c : p.out + O_YS + (size_t)(row - NP) * 1024 + c; *(float4*)o = make_float4(y0, y1, y2, y3); }
      }
    }
  }
}

DI void s5_carry(const Params& p, int j) {
  const char* matb = p.ws + W_S5MAT + (size_t)j * S5MAT_STRIDE;
  const float* ap8 = (const float*)(matb + S5_AP8);
  bf16_t* up = (bf16_t*)(p.ws + W_SB + SC_UP);
  const float* sloc = (const float*)(p.ws + W_SB + SC_SLOC);
  const int gt = blockIdx.x * 256 + otid(), nth = gridDim.x * 256;
  for (int idx = gt; idx < 32768; idx += nth) {
    const int b = idx >> 12, g = (idx >> 6) & 63, pp = idx & 63;
    const float ar = ap8[(g * 64 + pp) * 2], ai = ap8[(g * 64 + pp) * 2 + 1];
    float sr = 0.f, si = 0.f;
    for (int c0 = 0; c0 < 256; c0 += 16) {
      float lr_[16], li_[16];
#pragma unroll
      for (int u = 0; u < 16; ++u) { const size_t r = (size_t)b * 256 + c0 + u; lr_[u] = sloc[(r * 64 + g) * 128 + pp]; li_[u] = sloc[(r * 64 + g) * 128 + 64 + pp]; }
#pragma unroll
      for (int u = 0; u < 16; ++u) {
        const size_t r = (size_t)b * 256 + c0 + u;
        bf16_t* d = up + ((size_t)g * NR + r) * 256 + 128 + pp; d[0] = f2bf(sr); d[64] = f2bf(si);
        const float nr = ar * sr - ai * si + lr_[u], ni = ar * si + ai * sr + li_[u]; sr = nr; si = ni;
      }
    }
    p.out[O_S5RP + ((size_t)(j * 8 + b) * 64 + g) * 64 + pp] = sr;
    p.out[O_S5IP + ((size_t)(j * 8 + b) * 64 + g) * 64 + pp] = si;
  }
  for (int idx = gt; idx < 524288; idx += nth) {
    const int b = idx >> 12, g = (idx >> 6) & 63, pp = idx & 63;
    const float ar = ap8[(g * 64 + pp) * 2], ai = ap8[(g * 64 + pp) * 2 + 1];
    const size_t si_ = ((size_t)(j * 128 + b) * 64 + g) * 64 + pp;
    const float sr = p.in[2][si_], si = p.in[3][si_];
    const size_t r = 2048 + b;
    bf16_t* d = up + ((size_t)g * NR + r) * 256 + 128 + pp; d[0] = f2bf(sr); d[64] = f2bf(si);
    p.out[O_S5RS + si_] = ar * sr - ai * si + sloc[(r * 64 + g) * 128 + pp];
    p.out[O_S5IS + si_] = ar * si + ai * sr + sloc[(r * 64 + g) * 128 + 64 + pp];
  }
}

DI float gla_logdecay(const float* __restrict__ gl, const float (&wg)[16], float bias) {
  const float4 a = *(const float4*)gl, b = *(const float4*)(gl + 4), c = *(const float4*)(gl + 8), d = *(const float4*)(gl + 12);
  float x = bias;
  x += a.x * wg[0] + a.y * wg[1] + a.z * wg[2] + a.w * wg[3];
  x += b.x * wg[4] + b.y * wg[5] + b.z * wg[6] + b.w * wg[7];
  x += c.x * wg[8] + c.y * wg[9] + c.z * wg[10] + c.w * wg[11];
  x += d.x * wg[12] + d.y * wg[13] + d.z * wg[14] + d.w * wg[15];
  return -softplusf_(-x) * (1.0f / 16.0f);
}
DI void gla_prep_body(const bf16_t* __restrict__ P, const float* __restrict__ GL, const float* __restrict__ wgu, const float* __restrict__ bgate,
                      bf16_t* __restrict__ QT, bf16_t* __restrict__ KTL, bf16_t* __restrict__ KDT, float* __restrict__ DL, float* gls) {
  const int tid = otid(), kch = tid & 127, sub = tid >> 7, kp = swap23(kch);
  for (int it2 = blockIdx.x; it2 < 512; it2 += gridDim.x) {
    const int item = it2 * 2 + sub, b = item >> 7, h = (item >> 5) & 3, c = item & 31, tokc = b * 2048 + c * 64;
    { const float4* src = (const float4*)(GL + (size_t)tokc * 16); float4* d = (float4*)(gls + sub * 1024);
      d[kch] = src[kch]; d[kch + 128] = src[kch + 128]; }
    float wg[16];
#pragma unroll
    for (int r = 0; r < 16; ++r) wg[r] = wgu[r * 512 + h * 128 + kch];
    const float bias = bgate[h * 128 + kch];
    __syncthreads();
    float cum = 0.f;
#pragma unroll 8
    for (int t = 0; t < 64; ++t) {
      cum += gla_logdecay(gls + sub * 1024 + t * 16, wg, bias);
      const float qv = bf2f(P[(size_t)(tokc + t) * 3072 + h * 128 + kch]) * 0.08838834764831845f;
      const float kv = bf2f(P[(size_t)(tokc + t) * 3072 + 512 + h * 128 + kch]);
      const bf16_t kt = f2bf(kv * expf(-cum));
      QT[(size_t)(tokc + t) * 512 + h * 128 + kp] = f2bf(qv * expf(cum));
      KTL[(size_t)(tokc + t) * 512 + h * 128 + kp] = kt;
      KDT[((size_t)item * 128 + kch) * 64 + swap23(t)] = kt;
    }
    DL[(size_t)item * 128 + kch] = expf(cum);
    __syncthreads();
  }
}
DI void gla_prep(const Params& p, float* sm) {
  gla_prep_body((const bf16_t*)(p.ws + W_SB + SC_GLA_P), (const float*)(p.ws + W_SB + SC_GLA_GL), p.in[22], p.in[23],
                (bf16_t*)(p.ws + W_SB + SC_GLA_QT), (bf16_t*)(p.ws + W_SB + SC_GLA_KTL), (bf16_t*)(p.ws + W_SB + SC_GLA_KDT), (float*)(p.ws + W_SB + SC_GLA_DL), sm);
}
struct EpiGlaQK { bf16_t* A; int itemb;
  DI void one(int row, int col, float v) const {
    if ((row >> 6) != (col >> 6)) return;
    const int t = row & 63, s_ = col & 63;
    A[((size_t)(itemb + (row >> 6)) * 64 + t) * 64 + swap23(s_)] = (s_ <= t) ? f2bf(v) : (bf16_t)0;
  }
  DI void operator()(int row, int col, float v0, float v1) const { one(row, col, v0); one(row, col + 32, v1); } };
DI void gla_aqk(const Params& p, bf16_t* smem) {
  const bf16_t* QT = (const bf16_t*)(p.ws + W_SB + SC_GLA_QT); const bf16_t* KTL = (const bf16_t*)(p.ws + W_SB + SC_GLA_KTL);
  bf16_t* AQ = (bf16_t*)(p.ws + W_SB + SC_GLA_AQK);
  for (int t = blockIdx.x; t < 512; t += gridDim.x) {
    const int b = t >> 6, h = (t >> 4) & 3, cp = t & 15, tok0 = b * 2048 + cp * 128;
    EpiGlaQK e{AQ, (b * 4 + h) * 32 + cp * 2};
    gemm_tile(QT + (size_t)tok0 * 512 + h * 128, 512, KTL + (size_t)tok0 * 512 + h * 128, 512, 128, e, smem);
  }
}

DI void gla_rec(const Params& p, float* sm) {
  const bf16_t* P = (const bf16_t*)(p.ws + W_SB + SC_GLA_P);
  const float* GL = (const float*)(p.ws + W_SB + SC_GLA_GL);
  float* O = (float*)(p.ws + W_SB + SC_GLA_O);
  const int tid = otid(), lane = tid & 63;
  const int nseq = 64;
  const bool split = (int)gridDim.x > nseq;
  if (!split || (int)blockIdx.x < nseq) {
    const bf16_t* QT = (const bf16_t*)(p.ws + W_SB + SC_GLA_QT); const bf16_t* KDT = (const bf16_t*)(p.ws + W_SB + SC_GLA_KDT);
    const float* DL = (const float*)(p.ws + W_SB + SC_GLA_DL); const bf16_t* AQ = (const bf16_t*)(p.ws + W_SB + SC_GLA_AQK);
    const int w = tid >> 6, r = lane & 31, hh = lane >> 5;
    for (int blk = blockIdx.x; blk < nseq; blk += gridDim.x) {
      const int bh = blk >> 1, b = bh >> 2, h = bh & 3, v0 = (blk & 1) * 128 + w * 32;
      f32x16 S[4];
#pragma unroll
      for (int i = 0; i < 4; ++i)
#pragma unroll
        for (int q = 0; q < 16; ++q) S[i][q] = 0.f;
      const int r16 = tid >> 4, c16 = (tid & 15) * 8, r8 = tid >> 3, c8 = (tid & 7) * 8;
      uint4 gq0, gq1, gq2, gq3, ga0, ga1, gk0, gk1, gk2, gk3; float gdl;
      { const bf16_t* qG = QT + (size_t)(b * 2048) * 512 + h * 128; const bf16_t* aG = AQ + (size_t)(bh * 32) * 4096; const bf16_t* kdG = KDT + (size_t)(bh * 32) * 8192;
        gq0 = *(const uint4*)(qG + (size_t)(r16 + 0) * 512 + c16);
        gq1 = *(const uint4*)(qG + (size_t)(r16 + 16) * 512 + c16);
        gq2 = *(const uint4*)(qG + (size_t)(r16 + 32) * 512 + c16);
        gq3 = *(const uint4*)(qG + (size_t)(r16 + 48) * 512 + c16);
        ga0 = *(const uint4*)(aG + (r8 + 0) * 64 + c8);
        ga1 = *(const uint4*)(aG + (r8 + 32) * 64 + c8);
        gk0 = *(const uint4*)(kdG + (r8 + 0) * 64 + c8);
        gk1 = *(const uint4*)(kdG + (r8 + 32) * 64 + c8);
        gk2 = *(const uint4*)(kdG + (r8 + 64) * 64 + c8);
        gk3 = *(const uint4*)(kdG + (r8 + 96) * 64 + c8);
        gdl = (tid < 128) ? DL[(size_t)(bh * 32) * 128 + tid] : 0.f; }
      for (int c = 0; c < 32; ++c) {
        const int item = bh * 32 + c, tokc = b * 2048 + c * 64;
        float* dl = sm + 11264 + (c & 1) * 128;
        bf16_t* qS = (bf16_t*)sm; bf16_t* aS = qS + 64 * 136; bf16_t* kdS = aS + 64 * 72;
        if (tid < 128) dl[tid] = gdl;
        *(uint4*)(qS + (r16 + 0) * 136 + c16) = gq0;
        *(uint4*)(qS + (r16 + 16) * 136 + c16) = gq1;
        *(uint4*)(qS + (r16 + 32) * 136 + c16) = gq2;
        *(uint4*)(qS + (r16 + 48) * 136 + c16) = gq3;
        *(uint4*)(aS + (r8 + 0) * 72 + c8) = ga0;
        *(uint4*)(aS + (r8 + 32) * 72 + c8) = ga1;
        *(uint4*)(kdS + (r8 + 0) * 72 + c8) = gk0;
        *(uint4*)(kdS + (r8 + 32) * 72 + c8) = gk1;
        *(uint4*)(kdS + (r8 + 64) * 72 + c8) = gk2;
        *(uint4*)(kdS + (r8 + 96) * 72 + c8) = gk3;
        __syncthreads();
        if (c + 1 < 32) {
          { const bf16_t* qG = QT + (size_t)(tokc + 64) * 512 + h * 128; const bf16_t* aG = AQ + (size_t)(item + 1) * 4096; const bf16_t* kdG = KDT + (size_t)(item + 1) * 8192;
            gq0 = *(const uint4*)(qG + (size_t)(r16 + 0) * 512 + c16);
            gq1 = *(const uint4*)(qG + (size_t)(r16 + 16) * 512 + c16);
            gq2 = *(const uint4*)(qG + (size_t)(r16 + 32) * 512 + c16);
            gq3 = *(const uint4*)(qG + (size_t)(r16 + 48) * 512 + c16);
            ga0 = *(const uint4*)(aG + (r8 + 0) * 64 + c8);
            ga1 = *(const uint4*)(aG + (r8 + 32) * 64 + c8);
            gk0 = *(const uint4*)(kdG + (r8 + 0) * 64 + c8);
            gk1 = *(const uint4*)(kdG + (r8 + 32) * 64 + c8);
            gk2 = *(const uint4*)(kdG + (r8 + 64) * 64 + c8);
            gk3 = *(const uint4*)(kdG + (r8 + 96) * 64 + c8);
            gdl = (tid < 128) ? DL[(size_t)(item + 1) * 128 + tid] : 0.f; }
        }
        const bf16_t* qA = qS + r * 136 + 8 * hh;
        const bf16_t* aA = aS + r * 72 + 8 * hh;
        const bf16_t* kdA = kdS + r * 72 + 8 * hh;
        const bf16_t* vP = P + (size_t)tokc * 3072 + 1024 + h * 256 + v0 + r;
        bf16x8 sf[8];
        sf[0] = pack8<0>(S[0]); sf[1] = pack8<1>(S[0]); sf[2] = pack8<0>(S[1]); sf[3] = pack8<1>(S[1]);
        sf[4] = pack8<0>(S[2]); sf[5] = pack8<1>(S[2]); sf[6] = pack8<0>(S[3]); sf[7] = pack8<1>(S[3]);
        bf16x8 vf[4];
        const bf16_t* vrun = vP + (size_t)(4 * hh) * 3072;
#pragma unroll
        for (int f = 0; f < 4; ++f) {
#pragma unroll
          for (int j = 0; j < 8; ++j) vf[f][j] = (short)vrun[(size_t)((j & 3) + 8 * (j >> 2)) * 3072];
          vrun += (size_t)16 * 3072; asm volatile("" : "+v"(vrun));
        }
#pragma unroll
        for (int i = 0; i < 2; ++i) {
          f32x16 Oq;
#pragma unroll
          for (int q = 0; q < 16; ++q) Oq[q] = 0.f;
#pragma unroll
          for (int ks = 0; ks < 8; ++ks) {
            const bf16x8 qa = *(const bf16x8*)(qA + (32 * i) * 136 + ks * 16);
            Oq = __builtin_amdgcn_mfma_f32_32x32x16_bf16(qa, sf[ks], Oq, 0, 0, 0);
          }
#pragma unroll
          for (int ks = 0; ks < 4; ++ks) {
            const bf16x8 aa = *(const bf16x8*)(aA + (32 * i) * 72 + ks * 16);
            Oq = __builtin_amdgcn_mfma_f32_32x32x16_bf16(aa, vf[ks], Oq, 0, 0, 0);
          }
          {
            float* orun = O + (size_t)(tokc + 32 * i + 4 * hh) * 1024 + h * 256 + v0 + r;
#pragma unroll
            for (int q4 = 0; q4 < 4; ++q4) {
#pragma unroll
              for (int u = 0; u < 4; ++u) orun[(size_t)u * 1024] = Oq[q4 * 4 + u];
              orun += (size_t)8 * 1024; asm volatile("" : "+v"(orun));
            }
          }
        }
#pragma unroll
        for (int i = 0; i < 4; ++i) {
#pragma unroll
          for (int ks = 0; ks < 4; ++ks) {
            const bf16x8 ka = *(const bf16x8*)(kdA + (32 * i) * 72 + ks * 16);
            S[i] = __builtin_amdgcn_mfma_f32_32x32x16_bf16(ka, vf[ks], S[i], 0, 0, 0);
          }
#pragma unroll
          for (int q4 = 0; q4 < 4; ++q4) {
            const float4 d4 = *(const float4*)(dl + 32 * i + 8 * q4 + 4 * hh);
            S[i][q4 * 4 + 0] *= d4.x; S[i][q4 * 4 + 1] *= d4.y; S[i][q4 * 4 + 2] *= d4.z; S[i][q4 * 4 + 3] *= d4.w;
          }
        }
        __syncthreads();
      }
      float* so = p.out + O_GLAP + ((size_t)bh * 128) * 256 + v0 + r;
#pragma unroll
      for (int i = 0; i < 4; ++i)
#pragma unroll
        for (int q = 0; q < 16; ++q) so[(size_t)(32 * i + crow(q, hh)) * 256] = S[i][q];
      __syncthreads();
    }
  }
  if (!split || (int)blockIdx.x >= nseq) {
    const int first = split ? (int)blockIdx.x - nseq : (int)blockIdx.x, nb = split ? (int)gridDim.x - nseq : (int)gridDim.x;
    for (int item = first; item < 512; item += nb) {
      const int b = item >> 2, h = item & 3;
      const int L = 8, tok0 = NP + b * 8;
      float S[128];
      { const float* s0 = p.in[4] + ((size_t)(b * 4 + h) * 128) * 256 + tid;
#pragma unroll
        for (int k = 0; k < 128; ++k) S[k] = s0[(size_t)k * 256]; }
      float nd = 0.f, nq = 0.f, nkv = 0.f, nv;
      float wg[16]; float gbias = 0.f;
      if (tid < 128) {
#pragma unroll
        for (int r = 0; r < 16; ++r) wg[r] = p.in[22][r * 512 + h * 128 + tid];
        gbias = p.in[23][h * 128 + tid];
      } else {
#pragma unroll
        for (int r = 0; r < 16; ++r) wg[r] = 0.f;
      }
      {
        const size_t tok = tok0;
        if (tid < 128) { nd = expf(gla_logdecay(GL + tok * 16, wg, gbias)); nq = bf2f(P[tok * 3072 + h * 128 + tid]) * 0.08838834764831845f; nkv = bf2f(P[tok * 3072 + 512 + h * 128 + tid]); }
        nv = bf2f(P[tok * 3072 + 1024 + h * 256 + tid]);
      }
      for (int t = 0; t < L; ++t) {
        float* bb = sm + (t & 1) * 384;
        if (tid < 128) { bb[tid] = nd; bb[128 + tid] = nq; bb[256 + tid] = nkv; }
        const float vv = nv;
        __syncthreads();
        if (t + 1 < L) {
          const size_t tok = tok0 + t + 1;
          if (tid < 128) { nd = expf(gla_logdecay(GL + tok * 16, wg, gbias)); nq = bf2f(P[tok * 3072 + h * 128 + tid]) * 0.08838834764831845f; nkv = bf2f(P[tok * 3072 + 512 + h * 128 + tid]); }
          nv = bf2f(P[tok * 3072 + 1024 + h * 256 + tid]);
        }
        float o = 0.f;
#pragma unroll
        for (int c = 0; c < 8; ++c) {
#pragma unroll
          for (int k = c * 16; k < c * 16 + 16; ++k) { S[k] = bb[k] * S[k] + bb[256 + k] * vv; o += bb[128 + k] * S[k]; }
          __builtin_amdgcn_sched_barrier(0);
        }
        O[(size_t)(tok0 + t) * 1024 + h * 256 + tid] = o;
      }
      float* so = p.out + O_GLAS + ((size_t)(b * 4 + h) * 128) * 256 + tid;
#pragma unroll
      for (int k = 0; k < 128; ++k) so[(size_t)k * 256] = S[k];
      __syncthreads();
    }
  }
}

DI void gla_headnorm_body(const bf16_t* __restrict__ P, const float* __restrict__ O, bf16_t* __restrict__ OG, const float* __restrict__ gain) {
  const int lane = otid() & 63, wid = otid() >> 6;
  const float4 g4 = *(const float4*)(gain + lane * 4);
  for (int it0 = (blockIdx.x * 4 + wid) * 2; it0 < MT * 4; it0 += gridDim.x * 8) {
    float4 o[2]; uint2 rr[2];
#pragma unroll
    for (int u = 0; u < 2; ++u) { const int tok = (it0 + u) >> 2, h = (it0 + u) & 3;
      o[u] = *(const float4*)(O + (size_t)tok * 1024 + h * 256 + lane * 4); rr[u] = *(const uint2*)(P + (size_t)tok * 3072 + 2048 + h * 256 + lane * 4); }
#pragma unroll
    for (int u = 0; u < 2; ++u) { const int tok = (it0 + u) >> 2, h = (it0 + u) & 3;
      const float ss = wave_sum(o[u].x * o[u].x + o[u].y * o[u].y + o[u].z * o[u].z + o[u].w * o[u].w);
      const float rstd = rsqrtf(ss * (1.0f / 256.0f) + 1e-6f);
      const float r0 = __uint_as_float(rr[u].x << 16), r1 = __uint_as_float(rr[u].x & 0xffff0000u), r2 = __uint_as_float(rr[u].y << 16), r3 = __uint_as_float(rr[u].y & 0xffff0000u);
      uint2 w;
      w.x = pack2(o[u].x * rstd * g4.x * r0 * sigmoidf_(r0), o[u].y * rstd * g4.y * r1 * sigmoidf_(r1));
      w.y = pack2(o[u].z * rstd * g4.z * r2 * sigmoidf_(r2), o[u].w * rstd * g4.w * r3 * sigmoidf_(r3));
      *(uint2*)(OG + (size_t)tok * 1024 + h * 256 + lane * 4) = w; }
  }
}
DI void gla_headnorm(const Params& p) {
  gla_headnorm_body((const bf16_t*)(p.ws + W_SB + SC_GLA_P), (const float*)(p.ws + W_SB + SC_GLA_O), (bf16_t*)(p.ws + W_SB + SC_HN), p.in[24]);
}

DI void gdn_conv_body(const bf16_t* __restrict__ PRE, bf16_t* __restrict__ QKV, bf16_t* __restrict__ KT, const float* __restrict__ conv0,
                      const float* __restrict__ convw) {
  const int tid = otid(), c0 = tid * 16;
  float cw[4][16];
#pragma unroll
  for (int j = 0; j < 4; ++j)
#pragma unroll
    for (int i = 0; i < 16; ++i) cw[j][i] = convw[j * 4096 + c0 + i];
  for (int run = blockIdx.x; run < MT / 34; run += gridDim.x) {
    float x0[16], x1[16], x2[16];
    uint4 na, nb;
    { const uint4* src = (const uint4*)(PRE + (size_t)(run * 34) * 4096 + c0); na = src[0]; nb = src[1]; }
    for (int i = 0; i < 34; ++i) {
      const int tok = run * 34 + i;
      const int trunk = tok >= NP;
      const int b = trunk ? (tok - NP) >> 3 : tok >> 11, l = trunk ? (tok - NP) & 7 : tok & 2047;
      if (l == 0) {
        if (trunk) { const float* c = conv0 + (size_t)b * 3 * 4096 + c0;
#pragma unroll
          for (int q = 0; q < 16; ++q) { x0[q] = c[q]; x1[q] = c[4096 + q]; x2[q] = c[8192 + q]; } }
        else {
#pragma unroll
          for (int q = 0; q < 16; ++q) { x0[q] = 0.f; x1[q] = 0.f; x2[q] = 0.f; } }
      } else if (i == 0) {
#pragma unroll
        for (int jj = 0; jj < 3; ++jj) {
          const int lp = l - 3 + jj;
          float xr[16];
          if (lp >= 0) {
            const uint4* sp = (const uint4*)(PRE + (size_t)(tok - 3 + jj) * 4096 + c0);
            const uint4 a = sp[0], b2 = sp[1];
            const unsigned w[8] = {a.x, a.y, a.z, a.w, b2.x, b2.y, b2.z, b2.w};
#pragma unroll
            for (int q = 0; q < 8; ++q) { xr[2 * q] = __uint_as_float(w[q] << 16); xr[2 * q + 1] = __uint_as_float(w[q] & 0xffff0000u); }
          } else if (trunk) {
            const float* c = conv0 + ((size_t)b * 3 + (lp + 3)) * 4096 + c0;
#pragma unroll
            for (int q = 0; q < 16; ++q) xr[q] = c[q];
          } else {
#pragma unroll
            for (int q = 0; q < 16; ++q) xr[q] = 0.f;
          }
#pragma unroll
          for (int q = 0; q < 16; ++q) { if (jj == 0) x0[q] = xr[q]; else if (jj == 1) x1[q] = xr[q]; else x2[q] = xr[q]; }
        }
      }
      const unsigned wc[8] = {na.x, na.y, na.z, na.w, nb.x, nb.y, nb.z, nb.w};
      if (i + 1 < 34) { const uint4* src = (const uint4*)(PRE + (size_t)(tok + 1) * 4096 + c0); na = src[0]; nb = src[1]; }
      float cur[16], acc[16];
#pragma unroll
      for (int q = 0; q < 8; ++q) { cur[2 * q] = __uint_as_float(wc[q] << 16); cur[2 * q + 1] = __uint_as_float(wc[q] & 0xffff0000u); }
      float ss = 0.f;
#pragma unroll
      for (int q = 0; q < 16; ++q) {
        float a = x0[q] * cw[0][q] + x1[q] * cw[1][q] + x2[q] * cw[2][q] + cur[q] * cw[3][q];
        a = a * sigmoidf_(a); acc[q] = a; ss += a * a;
        x0[q] = x1[q]; x1[q] = x2[q]; x2[q] = cur[q];
      }
      ss += __shfl_xor(ss, 1); ss += __shfl_xor(ss, 2); ss += __shfl_xor(ss, 4);
      float sc = 1.0f;
      if (tid < 128) { sc = rsqrtf(ss + 1e-6f); if (tid < 64) sc *= 0.08838834764831845f; }
      float ov[16];
#pragma unroll
      for (int q = 0; q < 16; ++q) ov[q] = acc[q] * sc;
      if (!trunk && tid >= 64 && tid < 128) {
        const int kc = c0 - 1024, hq = kc >> 7, kch0 = kc & 127, chunk = l >> 6, tl = swap23(l & 63);
        bf16_t* kt = KT + ((size_t)((b * 8 + hq) * 32 + chunk) * 128 + kch0) * 64 + tl;
#pragma unroll
        for (int q = 0; q < 16; ++q) kt[q * 64] = f2bf(ov[q]);
      }
      if (tid < 128) {
#pragma unroll
        for (int q = 0; q < 16; ++q) if ((q & 4) && !(q & 8)) { const float tmp = ov[q]; ov[q] = ov[q + 4]; ov[q + 4] = tmp; }
      }
      uint4 o0, o1;
      o0.x = pack2(ov[0], ov[1]); o0.y = pack2(ov[2], ov[3]); o0.z = pack2(ov[4], ov[5]); o0.w = pack2(ov[6], ov[7]);
      o1.x = pack2(ov[8], ov[9]); o1.y = pack2(ov[10], ov[11]); o1.z = pack2(ov[12], ov[13]); o1.w = pack2(ov[14], ov[15]);
      uint4* dst = (uint4*)(QKV + (size_t)tok * 4096 + c0); dst[0] = o0; dst[1] = o1;
    }
  }
}
DI void gdn_gates_body(const float* __restrict__ BAr, float* __restrict__ GATES, const float* __restrict__ a_log, const float* __restrict__ dt_bias) {
  const int tid = otid(), lane = tid & 63, wid = tid >> 6;
  for (int it = blockIdx.x * 4 + wid; it < 4096; it += gridDim.x * 4) {
    const int h = it & 15, bc = it >> 4;
    const size_t tok = (size_t)bc * 64 + lane;
    const float beta = sigmoidf_(BAr[tok * 32 + h]);
    const float g = -expf(a_log[h]) * softplusf_(BAr[tok * 32 + 16 + h] + dt_bias[h]);
    float cum = g;
#pragma unroll
    for (int o = 1; o < 64; o <<= 1) { const float up = __shfl_up(cum, o); if (lane >= o) cum += up; }
    GATES[tok * 48 + h] = beta; GATES[tok * 48 + 16 + h] = g; GATES[tok * 48 + 32 + h] = cum;
  }
  const int gt = blockIdx.x * 256 + tid, nth = gridDim.x * 256;
  for (int idx = gt; idx < 1024 * 16; idx += nth) {
    const int h = idx & 15; const size_t tok = NP + (idx >> 4);
    GATES[tok * 48 + h] = sigmoidf_(BAr[tok * 32 + h]);
    GATES[tok * 48 + 16 + h] = -expf(a_log[h]) * softplusf_(BAr[tok * 32 + 16 + h] + dt_bias[h]);
  }
}
DI void gdn_conv(const Params& p) {
  gdn_conv_body((const bf16_t*)(p.ws + W_SB + SC_GDN_PRE), (bf16_t*)(p.ws + W_SB + SC_GDN_QKV), (bf16_t*)(p.ws + W_SB + SC_GDN_KT), p.in[6], p.in[27]);
  gdn_gates_body((const float*)(p.ws + W_SB + SC_GDN_BA), (float*)(p.ws + W_SB + SC_GDN_GATES), p.in[28], p.in[29]);
}

struct EpiKK { float* M; const float* GATES; int tok0, itemb, hq;
  DI void one(int row, int col, float v) const {
    if ((row >> 6) != (col >> 6)) return;
    const int t = row & 63, s_ = col & 63; if (s_ >= t) return;
    const float* gt_ = GATES + (size_t)(tok0 + row) * 48; const float* gs_ = GATES + (size_t)(tok0 + col) * 48;
#pragma unroll
    for (int hh = 0; hh < 2; ++hh) { const int h = hq * 2 + hh;
      M[((size_t)(itemb + h * 32 + (row >> 6)) * 64 + t) * 64 + s_] = gt_[h] * v * expf(gt_[32 + h] - gs_[32 + h]); }
  }
  DI void operator()(int row, int col, float v0, float v1) const { one(row, col, v0); one(row, col + 32, v1); } };
struct EpiQK { bf16_t* A; const float* GATES; int tok0, itemb, hq;
  DI void one(int row, int col, float v) const {
    if ((row >> 6) != (col >> 6)) return;
    const int t = row & 63, s_ = col & 63;
    const float* gt_ = GATES + (size_t)(tok0 + row) * 48; const float* gs_ = GATES + (size_t)(tok0 + col) * 48;
#pragma unroll
    for (int hh = 0; hh < 2; ++hh) { const int h = hq * 2 + hh;
      A[((size_t)(itemb + h * 32 + (row >> 6)) * 64 + t) * 64 + swap23(s_)] = (s_ <= t) ? f2bf(v * expf(gt_[32 + h] - gs_[32 + h])) : (bf16_t)0; }
  }
  DI void operator()(int row, int col, float v0, float v1) const { one(row, col, v0); one(row, col + 32, v1); } };

DI void gdn_kkqk(const Params& p, bf16_t* smem) {
  const bf16_t* QKV = (const bf16_t*)(p.ws + W_SB + SC_GDN_QKV);
  const float* GATES = (const float*)(p.ws + W_SB + SC_GDN_GATES);
  float* M = (float*)(p.ws + W_SB + SC_GDN_OM); bf16_t* AQ = (bf16_t*)(p.ws + W_SB + SC_GDN_AQK);
  for (int t = blockIdx.x; t < 1024; t += gridDim.x) {
    const int b = t >> 7, hq = (t >> 4) & 7, cp = t & 15, tok0 = b * 2048 + cp * 128;
    const bf16_t* kr = QKV + (size_t)tok0 * 4096 + 1024 + hq * 128; const bf16_t* qr = QKV + (size_t)tok0 * 4096 + hq * 128;
    EpiKK e1{M, GATES, tok0, b * 512 + cp * 2, hq};
    gemm_tile(kr, 4096, kr, 4096, 128, e1, smem);
    EpiQK e2{AQ, GATES, tok0, b * 512 + cp * 2, hq};
    gemm_tile(qr, 4096, kr, 4096, 128, e2, smem);
  }
}

DI void gdn_inverse(const Params& p, float* sm) {
  const float* M = (const float*)(p.ws + W_SB + SC_GDN_OM); bf16_t* TI = (bf16_t*)(p.ws + W_SB + SC_GDN_TINV);
  const int tid = otid(), lane = tid & 63, w = tid >> 6;
  float* Ms = sm + w * (64 * 68);
  const int nw = gridDim.x * 4;
  for (int base = 0; base < 4096; base += nw) {
    const int item = base + blockIdx.x * 4 + w;
    if (item < 4096) {
      const float* Mi = M + (size_t)item * 4096;
      for (int i = 1; i < 64; ++i) Ms[i * 68 + lane] = Mi[i * 64 + lane];
    }
    __syncthreads();
    if (item < 4096) {
      float x[64];
#pragma unroll
      for (int t = 0; t < 64; ++t) {
        float a = (t == lane) ? 1.0f : 0.0f;
#pragma unroll
        for (int s_ = 0; s_ < t; ++s_) a -= Ms[t * 68 + s_] * x[s_];
        x[t] = a;
      }
      bf16_t* To = TI + (size_t)item * 4096 + swap23(lane);
#pragma unroll
      for (int t = 0; t < 64; ++t) To[t * 64] = f2bf(x[t]);
    }
    __syncthreads();
  }
}

DI void gdn_rec(const Params& p, float* sm) {
  const bf16_t* QKV = (const bf16_t*)(p.ws + W_SB + SC_GDN_QKV);
  const float* GATES = (const float*)(p.ws + W_SB + SC_GDN_GATES);
  const bf16_t* TI = (const bf16_t*)(p.ws + W_SB + SC_GDN_TINV); const bf16_t* AQ = (const bf16_t*)(p.ws + W_SB + SC_GDN_AQK);
  const bf16_t* KT = (const bf16_t*)(p.ws + W_SB + SC_GDN_KT);
  bf16_t* O = (bf16_t*)(p.ws + W_SB + SC_GDN_OM);
  const int tid = otid(), lane = tid & 63;
  const int nseq = 128;
  const bool split = (int)gridDim.x > nseq;
  if (!split || (int)blockIdx.x < nseq) {
    const int w = tid >> 6, r = lane & 31, hh = lane >> 5, v0 = w * 32;
    for (int blk = blockIdx.x; blk < nseq; blk += gridDim.x) {
      const int b = blk >> 4, h = blk & 15, hq = h >> 1;
      f32x16 S[4];
#pragma unroll
      for (int i = 0; i < 4; ++i)
#pragma unroll
        for (int q = 0; q < 16; ++q) S[i][q] = 0.f;
      const int r16 = tid >> 4, c16 = (tid & 15) * 8, r8 = tid >> 3, c8 = (tid & 7) * 8;
      uint4 pt0, pt1, pa0, pa1, pk0, pk1, pk2, pk3;
      { const bf16_t* tG = TI + (size_t)(blk * 32) * 4096; const bf16_t* aG = AQ + (size_t)(blk * 32) * 4096; const bf16_t* ktG = KT + (size_t)((b * 8 + hq) * 32 + (0)) * 8192;
        pt0 = *(const uint4*)(tG + (r8 + 0) * 64 + c8); pa0 = *(const uint4*)(aG + (r8 + 0) * 64 + c8);
        pt1 = *(const uint4*)(tG + (r8 + 32) * 64 + c8); pa1 = *(const uint4*)(aG + (r8 + 32) * 64 + c8);
        pk0 = *(const uint4*)(ktG + (r8 + 0) * 64 + c8);
        pk1 = *(const uint4*)(ktG + (r8 + 32) * 64 + c8);
        pk2 = *(const uint4*)(ktG + (r8 + 64) * 64 + c8);
        pk3 = *(const uint4*)(ktG + (r8 + 96) * 64 + c8);
      }
      for (int c = 0; c < 32; ++c) {
        const int item = blk * 32 + c, tokc = b * 2048 + c * 64;
        float* bt = sm + 17920 + (c & 1) * 192; float* eg = bt + 64; float* dy = bt + 128;
        bf16_t* kS = (bf16_t*)sm; bf16_t* qS = kS + 64 * 136; bf16_t* tS = qS + 64 * 136; bf16_t* aS = tS + 64 * 72; bf16_t* ktS = aS + 64 * 72;
        {
          const bf16_t* kG = QKV + (size_t)tokc * 4096 + 1024 + hq * 128; const bf16_t* qG = QKV + (size_t)tokc * 4096 + hq * 128;
          uint4 gk[4], gq[4];
#pragma unroll
          for (int i = 0; i < 4; ++i) { gk[i] = *(const uint4*)(kG + (size_t)(r16 + 16 * i) * 4096 + c16); gq[i] = *(const uint4*)(qG + (size_t)(r16 + 16 * i) * 4096 + c16); }
          if (tid < 64) {
            const float* gp = GATES + (size_t)(tokc + tid) * 48;
            const float gc = gp[32 + h], gl = GATES[(size_t)(tokc + 63) * 48 + 32 + h];
            bt[tid] = gp[h]; eg[tid] = expf(gc); dy[tid] = expf(gl - gc);
          }
          *(uint4*)(tS + (r8 + 0) * 72 + c8) = pt0; *(uint4*)(tS + (r8 + 32) * 72 + c8) = pt1;
          *(uint4*)(aS + (r8 + 0) * 72 + c8) = pa0; *(uint4*)(aS + (r8 + 32) * 72 + c8) = pa1;
          *(uint4*)(ktS + (r8 + 0) * 72 + c8) = pk0; *(uint4*)(ktS + (r8 + 32) * 72 + c8) = pk1; *(uint4*)(ktS + (r8 + 64) * 72 + c8) = pk2; *(uint4*)(ktS + (r8 + 96) * 72 + c8) = pk3;
#pragma unroll
          for (int i = 0; i < 4; ++i) { *(uint4*)(kS + (r16 + 16 * i) * 136 + c16) = gk[i]; *(uint4*)(qS + (r16 + 16 * i) * 136 + c16) = gq[i]; }
        }
        __builtin_amdgcn_sched_barrier(0);
        __syncthreads();
        if (c + 1 < 32) {
          { const bf16_t* tG = TI + (size_t)(item + 1) * 4096; const bf16_t* aG = AQ + (size_t)(item + 1) * 4096; const bf16_t* ktG = KT + (size_t)((b * 8 + hq) * 32 + (c + 1)) * 8192;
            pt0 = *(const uint4*)(tG + (r8 + 0) * 64 + c8); pa0 = *(const uint4*)(aG + (r8 + 0) * 64 + c8);
            pt1 = *(const uint4*)(tG + (r8 + 32) * 64 + c8); pa1 = *(const uint4*)(aG + (r8 + 32) * 64 + c8);
            pk0 = *(const uint4*)(ktG + (r8 + 0) * 64 + c8);
            pk1 = *(const uint4*)(ktG + (r8 + 32) * 64 + c8);
            pk2 = *(const uint4*)(ktG + (r8 + 64) * 64 + c8);
            pk3 = *(const uint4*)(ktG + (r8 + 96) * 64 + c8);
          }
        }
        const bf16_t* kA = kS + r * 136 + 8 * hh;
        const bf16_t* qA = qS + r * 136 + 8 * hh;
        const bf16_t* tA = tS + r * 72 + 8 * hh;
        const bf16_t* aA = aS + r * 72 + 8 * hh;
        const bf16_t* ktA = ktS + r * 72 + 8 * hh;
        const bf16_t* vP = QKV + (size_t)tokc * 4096 + 2048 + h * 128 + v0 + r;
        f32x16 R[2];
        {
          bf16x8 sf[8];
          sf[0] = pack8<0>(S[0]); sf[1] = pack8<1>(S[0]); sf[2] = pack8<0>(S[1]); sf[3] = pack8<1>(S[1]);
          sf[4] = pack8<0>(S[2]); sf[5] = pack8<1>(S[2]); sf[6] = pack8<0>(S[3]); sf[7] = pack8<1>(S[3]);
#pragma unroll
          for (int i = 0; i < 2; ++i) {
#pragma unroll
            for (int q = 0; q < 16; ++q) R[i][q] = 0.f;
#pragma unroll
            for (int ks = 0; ks < 8; ++ks) {
              const bf16x8 ka = *(const bf16x8*)(kA + (32 * i) * 136 + ks * 16);
              R[i] = __builtin_amdgcn_mfma_f32_32x32x16_bf16(ka, sf[ks], R[i], 0, 0, 0);
            }
          }
        }
        __builtin_amdgcn_sched_barrier(0);
        const bf16_t* vrun = vP + (size_t)(4 * hh) * 4096;
#pragma unroll
        for (int i = 0; i < 2; ++i)
#pragma unroll
          for (int q4 = 0; q4 < 4; ++q4) {
            const float4 b4 = *(const float4*)(bt + 32 * i + 8 * q4 + 4 * hh); const float4 e4 = *(const float4*)(eg + 32 * i + 8 * q4 + 4 * hh);
            const float bb[4] = {b4.x, b4.y, b4.z, b4.w}, ee[4] = {e4.x, e4.y, e4.z, e4.w};
#pragma unroll
            for (int u = 0; u < 4; ++u) {
              const float vv = bf2f(vrun[(size_t)u * 4096]);
              R[i][q4 * 4 + u] = bb[u] * (vv - ee[u] * R[i][q4 * 4 + u]);
            }
            vrun += (size_t)8 * 4096; asm volatile("" : "+v"(vrun));
          }
        bf16x8 xf[4];
        xf[0] = pack8<0>(R[0]); xf[1] = pack8<1>(R[0]); xf[2] = pack8<0>(R[1]); xf[3] = pack8<1>(R[1]);
        f32x16 VN[2];
#pragma unroll
        for (int i = 0; i < 2; ++i) {
#pragma unroll
          for (int q = 0; q < 16; ++q) VN[i][q] = 0.f;
#pragma unroll
          for (int ks = 0; ks < 4; ++ks) {
            const bf16x8 ta = *(const bf16x8*)(tA + (32 * i) * 72 + ks * 16);
            VN[i] = __builtin_amdgcn_mfma_f32_32x32x16_bf16(ta, xf[ks], VN[i], 0, 0, 0);
          }
        }
        bf16x8 vf[4];
        vf[0] = pack8<0>(VN[0]); vf[1] = pack8<1>(VN[0]); vf[2] = pack8<0>(VN[1]); vf[3] = pack8<1>(VN[1]);
        __builtin_amdgcn_sched_barrier(0);
        f32x16 Oq[2];
        {
          bf16x8 sf[8];
          sf[0] = pack8<0>(S[0]); sf[1] = pack8<1>(S[0]); sf[2] = pack8<0>(S[1]); sf[3] = pack8<1>(S[1]);
          sf[4] = pack8<0>(S[2]); sf[5] = pack8<1>(S[2]); sf[6] = pack8<0>(S[3]); sf[7] = pack8<1>(S[3]);
#pragma unroll
          for (int i = 0; i < 2; ++i) {
#pragma unroll
            for (int q = 0; q < 16; ++q) Oq[i][q] = 0.f;
#pragma unroll
            for (int ks = 0; ks < 8; ++ks) {
              const bf16x8 qa = *(const bf16x8*)(qA + (32 * i) * 136 + ks * 16);
              Oq[i] = __builtin_amdgcn_mfma_f32_32x32x16_bf16(qa, sf[ks], Oq[i], 0, 0, 0);
            }
          }
        }
        __builtin_amdgcn_sched_barrier(0);
#pragma unroll
        for (int i = 0; i < 2; ++i) {
#pragma unroll
          for (int q4 = 0; q4 < 4; ++q4) {
            const float4 e4 = *(const float4*)(eg + 32 * i + 8 * q4 + 4 * hh);
            Oq[i][q4 * 4 + 0] *= e4.x; Oq[i][q4 * 4 + 1] *= e4.y; Oq[i][q4 * 4 + 2] *= e4.z; Oq[i][q4 * 4 + 3] *= e4.w;
          }
#pragma unroll
          for (int ks = 0; ks < 4; ++ks) {
            const bf16x8 aa = *(const bf16x8*)(aA + (32 * i) * 72 + ks * 16);
            Oq[i] = __builtin_amdgcn_mfma_f32_32x32x16_bf16(aa, vf[ks], Oq[i], 0, 0, 0);
          }
          {
            bf16_t* orun = O + (size_t)(tokc + 32 * i + 4 * hh) * 2048 + h * 128 + v0 + r;
#pragma unroll
            for (int q4 = 0; q4 < 4; ++q4) {
#pragma unroll
              for (int u = 0; u < 4; ++u) orun[(size_t)u * 2048] = f2bf(Oq[i][q4 * 4 + u]);
              orun += (size_t)8 * 2048; asm volatile("" : "+v"(orun));
            }
          }
        }
#pragma unroll
        for (int i = 0; i < 2; ++i)
#pragma unroll
          for (int q4 = 0; q4 < 4; ++q4) {
            const float4 d4 = *(const float4*)(dy + 32 * i + 8 * q4 + 4 * hh);
            VN[i][q4 * 4 + 0] *= d4.x; VN[i][q4 * 4 + 1] *= d4.y; VN[i][q4 * 4 + 2] *= d4.z; VN[i][q4 * 4 + 3] *= d4.w;
          }
        bf16x8 yf[4];
        yf[0] = pack8<0>(VN[0]); yf[1] = pack8<1>(VN[0]); yf[2] = pack8<0>(VN[1]); yf[3] = pack8<1>(VN[1]);
        const float egl = eg[63];
#pragma unroll
        for (int i = 0; i < 4; ++i) {
#pragma unroll
          for (int q = 0; q < 16; ++q) S[i][q] *= egl;
#pragma unroll
          for (int ks = 0; ks < 4; ++ks) {
            const bf16x8 ka = *(const bf16x8*)(ktA + (32 * i) * 72 + ks * 16);
            S[i] = __builtin_amdgcn_mfma_f32_32x32x16_bf16(ka, yf[ks], S[i], 0, 0, 0);
          }
        }
        __syncthreads();
      }
      float* so = p.out + O_GDNP + ((size_t)(b * 16 + h) * 128) * 128 + v0 + r;
#pragma unroll
      for (int i = 0; i < 4; ++i)
#pragma unroll
        for (int q = 0; q < 16; ++q) so[(size_t)(32 * i + crow(q, hh)) * 128] = S[i][q];
      __syncthreads();
    }
  }
  if (!split || (int)blockIdx.x >= nseq) {
    const int half = lane >> 5, v = (tid >> 6) * 32 + (lane & 31);
    const int first = split ? (int)blockIdx.x - nseq : (int)blockIdx.x, nb = split ? (int)gridDim.x - nseq : (int)gridDim.x;
    for (int item = first; item < 2048; item += nb) {
      const int b = item >> 4, h = item & 15;
      const int L = 8, tok0 = NP + b * 8, hq = h >> 1;
      float S[64];
      { const float* s0 = p.in[5] + ((size_t)(b * 16 + h) * 128 + half * 64) * 128 + v;
#pragma unroll
        for (int k = 0; k < 64; ++k) S[k] = s0[(size_t)k * 128]; }
      float nq = 0.f, nk = 0.f, nv, nbeta, ndec;
      const int pk = swap23(tid & 127);
      {
        const size_t tok = tok0;
        if (tid < 128) { nq = bf2f(QKV[tok * 4096 + hq * 128 + pk]); nk = bf2f(QKV[tok * 4096 + 1024 + hq * 128 + pk]); }
        nv = bf2f(QKV[tok * 4096 + 2048 + h * 128 + v]); nbeta = GATES[tok * 48 + h]; ndec = expf(GATES[tok * 48 + 16 + h]);
      }
      for (int t = 0; t < L; ++t) {
        float* qs = sm + (t & 1) * 256; float* ks = qs + 128;
        if (tid < 128) { qs[tid] = nq; ks[tid] = nk; }
        const float vv = nv, beta = nbeta, dec = ndec;
        __syncthreads();
        if (t + 1 < L) {
          const size_t tok = tok0 + t + 1;
          if (tid < 128) { nq = bf2f(QKV[tok * 4096 + hq * 128 + pk]); nk = bf2f(QKV[tok * 4096 + 1024 + hq * 128 + pk]); }
          nv = bf2f(QKV[tok * 4096 + 2048 + h * 128 + v]); nbeta = GATES[tok * 48 + h]; ndec = expf(GATES[tok * 48 + 16 + h]);
        }
        const float* kh = ks + half * 64; const float* qh = qs + half * 64;
        float dot = 0.f;
#pragma unroll
        for (int c = 0; c < 4; ++c) {
#pragma unroll
          for (int k = c * 16; k < c * 16 + 16; ++k) dot += kh[k] * S[k];
          __builtin_amdgcn_sched_barrier(0);
        }
        dot += __shfl_xor(dot, 32);
        const float vnew = beta * (vv - dec * dot);
        float o = 0.f;
#pragma unroll
        for (int c = 0; c < 4; ++c) {
#pragma unroll
          for (int k = c * 16; k < c * 16 + 16; ++k) { S[k] = dec * S[k] + kh[k] * vnew; o += qh[k] * S[k]; }
          __builtin_amdgcn_sched_barrier(0);
        }
        o += __shfl_xor(o, 32);
        if (half == 0) O[(size_t)(tok0 + t) * 2048 + h * 128 + v] = f2bf(o);
      }
      float* so = p.out + O_GDNS + ((size_t)(b * 16 + h) * 128 + half * 64) * 128 + v;
#pragma unroll
      for (int k = 0; k < 64; ++k) so[(size_t)k * 128] = S[k];
      __syncthreads();
    }
  }
}

DI void gdn_headnorm_body(const bf16_t* __restrict__ O, const bf16_t* __restrict__ Z, bf16_t* __restrict__ OG, const float* __restrict__ gain) {
  const int lane = otid() & 63, wid = otid() >> 6, sub = lane >> 4, l16 = lane & 15;
  float gn[8];
#pragma unroll
  for (int q = 0; q < 8; ++q) gn[q] = gain[l16 * 8 + q];
  for (int it0 = (blockIdx.x * 4 + wid) * 2; it0 < MT * 4; it0 += gridDim.x * 8) {
    uint4 ov[2], zv[2];
#pragma unroll
    for (int u = 0; u < 2; ++u) { const size_t off = (size_t)((it0 + u) >> 2) * 2048 + (((it0 + u) & 3) * 4 + sub) * 128 + l16 * 8;
      ov[u] = *(const uint4*)(O + off); zv[u] = *(const uint4*)(Z + off); }
#pragma unroll
    for (int u = 0; u < 2; ++u) { const size_t off = (size_t)((it0 + u) >> 2) * 2048 + (((it0 + u) & 3) * 4 + sub) * 128 + l16 * 8;
      const unsigned ow[4] = {ov[u].x, ov[u].y, ov[u].z, ov[u].w}, zw[4] = {zv[u].x, zv[u].y, zv[u].z, zv[u].w};
      float o[8], z[8]; float ss = 0.f;
#pragma unroll
      for (int q = 0; q < 4; ++q) { o[2 * q] = __uint_as_float(ow[q] << 16); o[2 * q + 1] = __uint_as_float(ow[q] & 0xffff0000u);
                                    z[2 * q] = __uint_as_float(zw[q] << 16); z[2 * q + 1] = __uint_as_float(zw[q] & 0xffff0000u); }
#pragma unroll
      for (int q = 0; q < 8; ++q) ss += o[q] * o[q];
      ss += __shfl_xor(ss, 1); ss += __shfl_xor(ss, 2); ss += __shfl_xor(ss, 4); ss += __shfl_xor(ss, 8);
      const float rstd = rsqrtf(ss * (1.0f / 128.0f) + 1e-6f);
      float y[8];
#pragma unroll
      for (int q = 0; q < 8; ++q) y[q] = o[q] * rstd * gn[q] * z[q] * sigmoidf_(z[q]);
      uint4 w; w.x = pack2(y[0], y[1]); w.y = pack2(y[2], y[3]); w.z = pack2(y[4], y[5]); w.w = pack2(y[6], y[7]);
      *(uint4*)(OG + off) = w; }
  }
}
DI void gdn_headnorm(const Params& p) {
  gdn_headnorm_body((const bf16_t*)(p.ws + W_SB + SC_GDN_OM), (const bf16_t*)(p.ws + W_SB + SC_GDN_Z), (bf16_t*)(p.ws + W_SB + SC_GDN_QKV), p.in[30]);
}


#define XB_TMO      128
#define XB_XCNT(j)  (256  + 64 * (j))
#define XB_XSUB(j)  (1280 + 64 * (j))
#define XB_XGEN(j)  (2304 + 64 * (j))
#define XB_TOP      3328
#define XB_TOPGEN   3392
#define XCD_BAR_WORDS 3456
#define XB_SPIN_CAP (1u << 20)
#define LAS __attribute__((address_space(3)))
DI unsigned xb_ld(unsigned* p)              { return __hip_atomic_load(p, __ATOMIC_RELAXED, __HIP_MEMORY_SCOPE_AGENT); }
DI unsigned xb_add(unsigned* p, unsigned v) { return __hip_atomic_fetch_add(p, v, __ATOMIC_RELAXED, __HIP_MEMORY_SCOPE_AGENT); }
DI unsigned xb_xcc_id() { return (unsigned)__builtin_amdgcn_s_getreg((3 << 11) | 20) & 0xFu; }
#define XB_SPIN(cond, bar) do { unsigned _sp = 0; while (cond) { __builtin_amdgcn_s_sleep(1); \
    if ((++_sp & 255u) == 0u) { if (xb_ld(&(bar)[XB_TMO])) break; if (_sp > XB_SPIN_CAP) { atomicAdd(&(bar)[XB_TMO], 1u); break; } } } } while (0)
struct XcdBarrier { unsigned* bar; unsigned x; volatile LAS unsigned* st; };
DI XcdBarrier xcd_barrier_post(unsigned* bar, volatile LAS unsigned* st) {
  XcdBarrier b; b.bar = bar; b.x = xb_xcc_id(); b.st = st;
  if (threadIdx.x == 0) (void)xb_add(&bar[XB_XCNT(b.x)], 1u);
  return b;
}
DI void xcd_barrier_complete(unsigned* bar, unsigned x, unsigned& nloc, unsigned& nx) {
  const unsigned G = gridDim.x * gridDim.y * gridDim.z;
  unsigned sum, cnt, mine, sp = 0u;
  for (;;) {
    sum = 0u; cnt = 0u; mine = 0u;
#pragma unroll
    for (unsigned j = 0; j < 16; ++j) { const unsigned c = xb_ld(&bar[XB_XCNT(j)]); sum += c; cnt += (c > 0u) ? 1u : 0u; mine = (j == x) ? c : mine; }
    if (sum == G) break;
    __builtin_amdgcn_s_sleep(1);
    if ((++sp & 255u) == 0u) { if (xb_ld(&bar[XB_TMO])) break; if (sp > XB_SPIN_CAP) { atomicAdd(&bar[XB_TMO], 1u); break; } }
  }
  nloc = mine > 0u ? mine : 1u; nx = cnt > 0u ? cnt : 1u;
}
DI void xcd_barrier(const XcdBarrier& b) {
  asm volatile("s_waitcnt vmcnt(0)" ::: "memory");
  __syncthreads();
  if (threadIdx.x == 0) {
    unsigned* bar = b.bar;
    __builtin_amdgcn_s_waitcnt(0);
    unsigned nloc = b.st[0], nx = b.st[1];
    if (nloc == 0u) { xcd_barrier_complete(bar, b.x, nloc, nx); b.st[0] = nloc; b.st[1] = nx; }
    const unsigned old = xb_add(&bar[XB_XSUB(b.x)], 1u);
    const unsigned gen = old / nloc;
    if (old + 1u == (gen + 1u) * nloc) {
      __builtin_amdgcn_fence(__ATOMIC_RELEASE, "agent");
      asm volatile("s_waitcnt vmcnt(0)" ::: "memory");
      const unsigned og = xb_add(&bar[XB_TOP], 1u);
      const unsigned tg = og / nx;
      if (og + 1u == (tg + 1u) * nx) xb_add(&bar[XB_TOPGEN], 1u);
      else XB_SPIN(xb_ld(&bar[XB_TOPGEN]) == tg, bar);
      __builtin_amdgcn_fence(__ATOMIC_ACQUIRE, "agent");
      xb_add(&bar[XB_XGEN(b.x)], 1u);
      asm volatile("s_waitcnt vmcnt(0)" ::: "memory");
    } else {
      XB_SPIN(xb_ld(&bar[XB_XGEN(b.x)]) == gen, bar);
      __builtin_amdgcn_fence(__ATOMIC_ACQUIRE, "agent");
      asm volatile("s_waitcnt vmcnt(0)" ::: "memory");
    }
  }
  __syncthreads();
}
template <int layer>
DI void layer_body(const Params& p, const XcdBarrier& xb, bf16_t* smem, float* smf) {
  char* ws = p.ws;
  float* H = (float*)(ws + W_H);
  bf16_t* wt_up = (bf16_t*)(ws + W_UP); bf16_t* wt_down = (bf16_t*)(ws + W_DOWN);
  bf16_t* wt_in = (bf16_t*)(ws + W_MIXIN); bf16_t* wt_out = (bf16_t*)(ws + W_MIXOUT);
  bf16_t* HN = (bf16_t*)(ws + W_SB + SC_HN); bf16_t* ACT = (bf16_t*)(ws + W_SB + SC_ACT);
    const int kind = layer % 3, j = layer / 3;
    REPM1 convert_w<0>(p.in[10] + (size_t)layer * 1024 * 4096, 1024, 4096, wt_up, 4096, smf);
    REPM1 convert_w<0>(p.in[11] + (size_t)layer * 4096 * 1024, 4096, 1024, wt_down, 1024, smf);
    if (kind == 0) {
      REPM1 convert_w<1>(p.in[20] + (size_t)j * 1024 * 2048, 1024, 2048, wt_in, 2048, smf);
      REPM1 norm_phase<1>(p, p.in[7] + layer * 1024, layer == 0, (bf16_t*)(ws + W_SB + SC_UP));
    } else if (kind == 1) {
      REPM1 convert_w<0>(p.in[21], 1024, 3088, wt_in, 3200, smf);
      REPM1 convert_w<0>(p.in[25], 1024, 1024, wt_out, 1024, smf);
      REPM1 norm_phase<0>(p, p.in[7] + layer * 1024, false, HN);
    } else {
      REPM1 convert_w<0>(p.in[26], 1024, 6176, wt_in, 6272, smf);
      REPM1 convert_w<0>(p.in[31], 2048, 1024, wt_out, 1024, smf);
      REPM1 norm_phase<0>(p, p.in[7] + layer * 1024, false, (bf16_t*)(ws + W_SB + SC_GDN_QKV));
    }
    GSYNC();
    if (kind == 0) {
      const char* matb = ws + W_S5MAT + (size_t)j * S5MAT_STRIDE;
      const bf16_t* wcat = (const bf16_t*)(matb + S5_WCAT); const bf16_t* wst = (const bf16_t*)(matb + S5_WST);
      bf16_t* up = (bf16_t*)(ws + W_SB + SC_UP); float* sloc = (float*)(ws + W_SB + SC_SLOC); bf16_t* gbuf = (bf16_t*)(ws + W_SB + SC_GBUF);
      REPG for (int t = blockIdx.x; t < 17 * 64; t += gridDim.x) {
        const int g = t / 17, mt = t % 17;
        EpiS5Loc e{sloc, mt * 128, g};
        gemm_tile(up + ((size_t)g * NR + mt * 128) * 256, 256, wst + (size_t)g * 128 * 128, 128, 128, e, smem);
      }
      GSYNC();
      REPM2 s5_carry(p, j);
      GSYNC();
      REPG for (int t = blockIdx.x; t < 17 * 64; t += gridDim.x) {
        const int g = t / 17, mt = t % 17;
        EpiS5Out e{up, p.in[19] + j * 1024, gbuf, mt * 128, g};
        gemm_tile(up + ((size_t)g * NR + mt * 128) * 256, 256, wcat + (size_t)g * 128 * 256, 256, 256, e, smem);
      }
      GSYNC();
      for (int t = blockIdx.x; t < 136 * 16; t += gridDim.x) {
        const int mt = t / 16, nt = t % 16;
        EpiGLU e{H, mt * 128, nt * 128};
        gemm_tile(gbuf + (size_t)mt * 128 * 1024, 1024, wt_in + (size_t)nt * 128 * 1024, 1024, 1024, e, smem);
      }
      GSYNC();
    } else if (kind == 1) {
      bf16_t* P = (bf16_t*)(ws + W_SB + SC_GLA_P); float* GL = (float*)(ws + W_SB + SC_GLA_GL);
      REPG for (int t = blockIdx.x; t < 136 * 25; t += gridDim.x) {
        const int mt = t / 25, nt = t % 25;
        EpiGlaIn e{P, GL, mt * 128, nt * 128};
        gemm_tile(HN + (size_t)mt * 128 * 1024, 1024, wt_in + (size_t)nt * 128 * 1024, 1024, 1024, e, smem);
      }
      GSYNC();
      REPM3 gla_prep(p, smf);
      GSYNC();
      REPG gla_aqk(p, smem);
      GSYNC();
      for (int rep = 0; rep < DUP_REC; ++rep) gla_rec(p, smf);
      GSYNC();
      REPM3 gla_headnorm(p);
      GSYNC();
      for (int t = blockIdx.x; t < 136 * 8; t += gridDim.x) {
        const int mt = t / 8, nt = t % 8;
        EpiResid e{H, mt * 128, nt * 128};
        gemm_tile(HN + (size_t)mt * 128 * 1024, 1024, wt_out + (size_t)nt * 128 * 1024, 1024, 1024, e, smem);
      }
      GSYNC();
    } else {
      bf16_t* hn2 = (bf16_t*)(ws + W_SB + SC_GDN_QKV);
      REPG for (int t = blockIdx.x; t < 136 * 49; t += gridDim.x) {
        const int mt = t / 49, nt = t % 49;
        EpiGdnIn e{(bf16_t*)(ws + W_SB + SC_GDN_PRE), (bf16_t*)(ws + W_SB + SC_GDN_Z), (float*)(ws + W_SB + SC_GDN_BA), p.out + O_CONVP, p.out + O_CONVS, mt * 128, nt * 128};
        gemm_tile(hn2 + (size_t)mt * 128 * 1024, 1024, wt_in + (size_t)nt * 128 * 1024, 1024, 1024, e, smem);
      }
      GSYNC();
      REPM4 gdn_conv(p);
      GSYNC();
      REPG gdn_kkqk(p, smem);
      GSYNC();
      REPM4 gdn_inverse(p, smf);
      GSYNC();
      for (int rep = 0; rep < DUP_REC; ++rep) gdn_rec(p, smf);
      GSYNC();
      REPM4 gdn_headnorm(p);
      GSYNC();
      for (int t = blockIdx.x; t < 136 * 8; t += gridDim.x) {
        const int mt = t / 8, nt = t % 8;
        EpiResid e{H, mt * 128, nt * 128};
        gemm_tile(hn2 + (size_t)mt * 128 * 2048, 2048, wt_out + (size_t)nt * 128 * 2048, 2048, 2048, e, smem);
      }
      GSYNC();
    }
    REPM1 norm_phase<0>(p, p.in[8] + layer * 1024, false, HN);
    GSYNC();
    for (int rep = 0; rep < DUP_UP; ++rep)
    for (int t = blockIdx.x; t < 136 * 32; t += gridDim.x) {
      const int mt = t / 32, nt = t % 32;
      EpiRelu2 e{ACT, mt * 128, nt * 128};
      gemm_tile(HN + (size_t)mt * 128 * 1024, 1024, wt_up + (size_t)nt * 128 * 1024, 1024, 1024, e, smem);
    }
    GSYNC();
    for (int t = blockIdx.x; t < 136 * 8; t += gridDim.x) {
      const int nt = t / 136, mt = t % 136;
      EpiResid e{H, mt * 128, nt * 128};
      gemm_tile(ACT + (size_t)mt * 128 * 4096, 4096, wt_down + (size_t)nt * 128 * 4096, 4096, 4096, e, smem);
    }
    GSYNC();
  }

__global__ void __launch_bounds__(256, 2) fwd_megakernel(Params p) {
  __shared__ __attribute__((aligned(16))) char smem_raw[73728];
  __shared__ uint4 xb_words;
  cg::grid_group grid = cg::this_grid();
  unsigned* barw = (unsigned*)(p.ws + W_BAR);
  if (threadIdx.x == 0) xb_words = make_uint4(0u, 0u, 0u, 0u);
  __syncthreads();
  if (p.ws == nullptr) grid.sync();
  XcdBarrier xb = xcd_barrier_post(barw, (volatile LAS unsigned*)&xb_words);
  bf16_t* smem = (bf16_t*)smem_raw;
  float* smf = (float*)smem_raw;
  char* ws = p.ws;
  float* H = (float*)(ws + W_H);
  bf16_t* wt_up = (bf16_t*)(ws + W_UP); bf16_t* wt_down = (bf16_t*)(ws + W_DOWN);
  bf16_t* wt_in = (bf16_t*)(ws + W_MIXIN); bf16_t* wt_out = (bf16_t*)(ws + W_MIXOUT);
  bf16_t* HN = (bf16_t*)(ws + W_SB + SC_HN); bf16_t* ACT = (bf16_t*)(ws + W_SB + SC_ACT);

  REPM2 s5_mats(p, smf);

  layer_body<0>(p, xb, smem, smf);
  layer_body<1>(p, xb, smem, smf);
  layer_body<2>(p, xb, smem, smf);
  layer_body<3>(p, xb, smem, smf);
  REPM1 norm_phase<2>(p, p.in[9], false, nullptr);
}

extern "C" void kernel_launch(void* const* d_in, const int* in_sizes, int n_in, void* d_out, int out_size,
                              void* d_ws, size_t ws_size, hipStream_t stream) {
  static int grid_blocks = 0;
  if (!grid_blocks) {
    int dev = 0, cus = 0, per_cu = 0;
    hipGetDevice(&dev);
    hipDeviceGetAttribute(&cus, hipDeviceAttributeMultiprocessorCount, dev);
    hipOccupancyMaxActiveBlocksPerMultiprocessor(&per_cu, fwd_megakernel, 256, 0);
    if (per_cu > 2) per_cu = 2;
    if (per_cu < 1) per_cu = 1;
    grid_blocks = cus * per_cu;
  }
  if (ws_size < WS_NEED) fprintf(stderr, "workspace too small: %zu < %zu\n", ws_size, (size_t)WS_NEED);
  Params p{};
  for (int i = 0; i < 32; ++i) p.in[i] = (const float*)d_in[i];
  p.out = (float*)d_out; p.ws = (char*)d_ws;
  hipMemsetAsync((char*)d_ws + W_BAR, 0, XCD_BAR_WORDS * sizeof(unsigned), stream);
  void* args[] = {&p};
  hipError_t e = hipLaunchCooperativeKernel((void*)fwd_megakernel, dim3(grid_blocks), dim3(256), args, 0, stream);
  if (e != hipSuccess) fprintf(stderr, "cooperative launch failed: %s (grid %d)\n", hipGetErrorString(e), grid_blocks);
}
```
